# Optimizing an MI355X kernel written in HIP

```python
import jax
import jax.numpy as jnp
from jax import lax
import numpy as np

D_MODEL = 1024
BATCH = 16
SEQ = 2048
DEPTH = 4

CTX_LEN = 256
GRID_W = 64
EPS = 1e-6

GLA_HEADS = 4
GLA_DK = 48
GLA_DV = 96
GLA_QK = GLA_HEADS * GLA_DK
GLA_WIDTH = GLA_HEADS * GLA_DV
GLA_LOWRANK = 16
GLA_TAU = 16.0
GLA_CHUNK = 64
ROPE_BASE = 10000.0

NA_HEADS = 6
NA_DH = 64
NA_WIDTH = NA_HEADS * NA_DH
NA_KH = 8
NA_KW = 16

CONV_WIDTH = 256
CONV_K = 31

MIX_WIDTH = GLA_WIDTH + NA_WIDTH + CONV_WIDTH
IN_SIZES = (GLA_QK, GLA_QK, GLA_WIDTH, GLA_WIDTH, 2 * GLA_LOWRANK, NA_WIDTH, NA_WIDTH, NA_WIDTH, 2 * CONV_WIDTH)
IN_COLS = sum(IN_SIZES)

N_EXPERTS = 16
N_GROUPS = 4
EXPERTS_PER_GROUP = N_EXPERTS // N_GROUPS
TOP_K = 2
D_FF_EXPERT = 1024
MOE_BLOCK = 256

kernel_name = 'hybrid_gla_natten_conformer_groupmoe_dit'


def rmsnorm(x, g):
    xf = x.astype(jnp.float32)
    y = xf * lax.rsqrt(jnp.mean(xf * xf, axis=-1, keepdims=True) + EPS)
    return (y * g.astype(jnp.float32)).astype(x.dtype)


def layernorm(x, g, b):
    xf = x.astype(jnp.float32)
    xc = xf - jnp.mean(xf, axis=-1, keepdims=True)
    y = xc * lax.rsqrt(jnp.mean(xc * xc, axis=-1, keepdims=True) + EPS)
    return (y * g.astype(jnp.float32) + b.astype(jnp.float32)).astype(x.dtype)


def to_heads(a, n_heads):
    bb, n, _ = a.shape
    return a.reshape(bb, n, n_heads, -1).transpose(0, 2, 1, 3)


def from_heads(a):
    bb, h, n, d = a.shape
    return a.transpose(0, 2, 1, 3).reshape(bb, n, h * d)


def axial_rope(n, dim):
    t = jnp.arange(n)
    row = (t // GRID_W).astype(jnp.float32)
    col = (t % GRID_W).astype(jnp.float32)
    half = dim // 2
    inv = ROPE_BASE ** (-jnp.arange(0, half, 2, dtype=jnp.float32) / half)
    ang = jnp.concatenate([row[:, None] * inv, col[:, None] * inv], axis=-1)
    return jnp.cos(ang), jnp.sin(ang)


def apply_rope(x, cos, sin):
    cos = cos.astype(x.dtype)
    sin = sin.astype(x.dtype)
    x1, x2 = x[..., 0::2], x[..., 1::2]
    return jnp.stack([x1 * cos - x2 * sin, x1 * sin + x2 * cos], axis=-1).reshape(x.shape)


def gla_scan(q, k, v, log_g, s0):
    bb, h, n, dk = q.shape
    dv = v.shape[-1]
    nc = n // GLA_CHUNK
    order_mask = jnp.tril(jnp.ones((GLA_CHUNK, GLA_CHUNK), dtype=bool))[:, :, None]

    def chunks(a):
        return jnp.moveaxis(a.reshape(bb, h, nc, GLA_CHUNK, a.shape[-1]), 2, 0)

    def step(state, inp):
        qc, kc, vc, gc = [t.astype(jnp.float32) for t in inp]
        cum = jnp.cumsum(gc, axis=2)
        o_inter = jnp.einsum('bhtd,bhde->bhte', qc * jnp.exp(cum), state)
        decay = jnp.exp(jnp.where(order_mask, cum[:, :, :, None, :] - cum[:, :, None, :, :], -jnp.inf))
        att = jnp.einsum('bhtd,bhsd,bhtsd->bhts', qc, kc, decay)
        o = o_inter + jnp.einsum('bhts,bhse->bhte', att, vc)
        end = cum[:, :, -1:, :]
        new_state = (jnp.exp(end[:, :, 0, :])[..., None] * state
                     + jnp.einsum('bhsd,bhse->bhde', kc * jnp.exp(end - cum), vc))
        return new_state, o

    s_fin, o = lax.scan(step, s0, (chunks(q), chunks(k), chunks(v), chunks(log_g)))
    return jnp.moveaxis(o, 0, 2).reshape(bb, h, n, dv).astype(v.dtype), s_fin


def gla_inputs(q, k, v, a, wa_f, ba_f, wa_b, ba_b):
    q = to_heads(q, GLA_HEADS) * (GLA_DK ** -0.5)
    k = to_heads(k, GLA_HEADS)
    v = to_heads(v, GLA_HEADS)
    a_f, a_b = jnp.split(a, 2, axis=-1)
    g_f = to_heads(jax.nn.log_sigmoid((a_f @ wa_f + ba_f).astype(jnp.float32)) / GLA_TAU, GLA_HEADS)
    g_b = to_heads(jax.nn.log_sigmoid((a_b @ wa_b + ba_b).astype(jnp.float32)) / GLA_TAU, GLA_HEADS)
    return q, k, v, g_f, g_b


def gla_bidir(q, k, v, g_f, g_b, s_f, s_b):
    o_f, s_f_new = gla_scan(q, k, v, g_f, s_f)
    flip = lambda t: jnp.flip(t, axis=2)
    o_b, s_b_new = gla_scan(flip(q), flip(k), flip(v), flip(g_b), s_b)
    return o_f + flip(o_b), s_f_new, s_b_new


def gla_output(o, gate, g_norm):
    of = o.astype(jnp.float32)
    of = of * lax.rsqrt(jnp.mean(of * of, axis=-1, keepdims=True) + EPS)
    of = from_heads(of) * g_norm.astype(jnp.float32)
    return of.astype(gate.dtype) * jax.nn.silu(gate)


def na_heads(q, k, v):
    return to_heads(q, NA_HEADS) * (NA_DH ** -0.5), to_heads(k, NA_HEADS), to_heads(v, NA_HEADS)


def na_latent(q, k, v, kc, vc, rpb):
    bb, h, n, dh = q.shape
    rows = n // GRID_W
    kh = min(NA_KH, rows)
    kw = NA_KW
    cq = np.arange(GRID_W)
    c0 = np.clip(cq - kw // 2, 0, GRID_W - kw)
    colidx = c0[:, None] + np.arange(kw)[None, :]
    dcol = colidx - cq[:, None] + (NA_KW - 1)
    kg = k.reshape(bb, h, rows, GRID_W, dh)
    vg = v.reshape(bb, h, rows, GRID_W, dh)
    q_rows = jnp.moveaxis(q.reshape(bb, h, rows, GRID_W, dh), 2, 0)

    def row_block(args):
        qr, r = args
        r0 = jnp.clip(r - kh // 2, 0, rows - kh)
        kb = lax.dynamic_slice_in_dim(kg, r0, kh, axis=2)[:, :, :, colidx]
        vb = lax.dynamic_slice_in_dim(vg, r0, kh, axis=2)[:, :, :, colidx]
        drow = r0 + jnp.arange(kh) - r + (NA_KH - 1)
        bias = jnp.transpose(rpb[:, drow][:, :, dcol], (0, 2, 1, 3))
        s_loc = jnp.einsum('bhqd,bhiqjd->bhqij', qr, kb).astype(jnp.float32) + bias.astype(jnp.float32)
        s_ctx = jnp.einsum('bhqd,bhld->bhql', qr, kc).astype(jnp.float32)
        s = jnp.concatenate([s_loc.reshape(bb, h, GRID_W, kh * kw), s_ctx], axis=-1)
        p = jax.nn.softmax(s, axis=-1).astype(v.dtype)
        p_loc = p[..., :kh * kw].reshape(bb, h, GRID_W, kh, kw)
        return (jnp.einsum('bhqij,bhiqjd->bhqd', p_loc, vb)
                + jnp.einsum('bhql,bhld->bhqd', p[..., kh * kw:], vc))

    o = lax.map(row_block, (q_rows, jnp.arange(rows)))
    return jnp.moveaxis(o, 0, 2).reshape(bb, h, n, dh)


def na_context(qc, kc, vc):
    s = jnp.einsum('bhqd,bhkd->bhqk', qc, kc).astype(jnp.float32)
    p = jax.nn.softmax(s, axis=-1).astype(vc.dtype)
    return jnp.einsum('bhqk,bhkd->bhqd', p, vc)


def conv_module(u, w_dw, b_dw, ln_g, ln_b):
    a, gate = jnp.split(u, 2, axis=-1)
    hcv = a * jax.nn.sigmoid(gate)
    hcv = lax.conv_general_dilated(
        hcv, w_dw[:, None, :].astype(hcv.dtype), window_strides=(1,),
        padding=((CONV_K // 2, CONV_K // 2),), dimension_numbers=('NWC', 'WIO', 'NWC'),
        feature_group_count=CONV_WIDTH) + b_dw
    return jax.nn.silu(layernorm(hcv, ln_g, ln_b))


def moe(h, router_w, router_bias, wg, wu, wd):
    t, d = h.shape
    aff = jax.nn.sigmoid((h @ router_w).astype(jnp.float32))
    sel = aff + router_bias.astype(jnp.float32)
    gscore = lax.top_k(sel.reshape(t, N_GROUPS, EXPERTS_PER_GROUP), TOP_K)[0].sum(-1)
    gbest = jnp.argmax(gscore, axis=-1)
    in_group = (jnp.arange(N_EXPERTS) // EXPERTS_PER_GROUP)[None, :] == gbest[:, None]
    _, eidx = lax.top_k(jnp.where(in_group, sel, -jnp.inf), TOP_K)
    w = jnp.take_along_axis(aff, eidx, axis=-1)
    w = w / jnp.sum(w, axis=-1, keepdims=True)
    flat_e = eidx.reshape(-1)
    flat_tok = jnp.repeat(jnp.arange(t, dtype=jnp.int32), TOP_K)
    flat_w = w.reshape(-1)
    n_slots = flat_e.shape[0]
    order = jnp.argsort(flat_e)
    e_s, tok_s, w_s = flat_e[order], flat_tok[order], flat_w[order]
    counts = jnp.bincount(flat_e, length=N_EXPERTS)
    padded = (counts + MOE_BLOCK - 1) // MOE_BLOCK * MOE_BLOCK
    pad_end = jnp.cumsum(padded)
    pad_start = pad_end - padded
    start = jnp.cumsum(counts) - counts
    dest = pad_start[e_s] + jnp.arange(n_slots) - start[e_s]
    n_blocks = -(-n_slots // MOE_BLOCK) + N_EXPERTS
    p_rows = n_blocks * MOE_BLOCK
    row_tok = jnp.full((p_rows,), t, jnp.int32).at[dest].set(tok_s)
    row_w = jnp.zeros((p_rows,), h.dtype).at[dest].set(w_s.astype(h.dtype))
    blk_e = jnp.minimum(jnp.sum(pad_end[None, :] <= (jnp.arange(n_blocks) * MOE_BLOCK)[:, None], axis=-1),
                        N_EXPERTS - 1)
    h_pad = jnp.concatenate([h, jnp.zeros((1, d), h.dtype)], axis=0)
    xb = h_pad[row_tok].reshape(n_blocks, MOE_BLOCK, d)

    def expert_block(args):
        xe, e = args
        return (jax.nn.silu(xe @ wg[e]) * (xe @ wu[e])) @ wd[e]

    yb = lax.map(expert_block, (xb, blk_e)).reshape(p_rows, d)
    out = jnp.zeros((t + 1, d), h.dtype).at[row_tok].add(yb * row_w[:, None])
    return out[:t]


def setup_inputs(seed: int = 0) -> dict:
    key = jax.random.key(seed)
    ks = iter(jax.random.split(key, 40))
    nrm = lambda shape, s: jax.random.normal(next(ks), shape, jnp.float32) * s
    L, D = DEPTH, D_MODEL
    return {
        'x': nrm((BATCH, SEQ, D), 1.0),
        'c': nrm((BATCH, D), 1.0),
        'ctx': nrm((BATCH, CTX_LEN, D), 1.0),
        'c_ctx': nrm((D,), 1.0),
        'w_mod': nrm((L, D, 6 * D), 0.5 * D ** -0.5),
        'b_mod': nrm((L, 6 * D), 0.01),
        'g_mix': 1.0 + nrm((L, D), 0.01),
        'g_ffn': 1.0 + nrm((L, D), 0.01),
        'w_in': nrm((L, D, IN_COLS), D ** -0.5),
        'gla_wa_f': nrm((L, GLA_LOWRANK, GLA_QK), GLA_LOWRANK ** -0.5),
        'gla_ba_f': nrm((L, GLA_QK), 0.01),
        'gla_wa_b': nrm((L, GLA_LOWRANK, GLA_QK), GLA_LOWRANK ** -0.5),
        'gla_ba_b': nrm((L, GLA_QK), 0.01),
        'gla_g_norm': 1.0 + nrm((L, GLA_WIDTH), 0.01),
        'na_rpb': nrm((L, NA_HEADS, 2 * NA_KH - 1, 2 * NA_KW - 1), 0.1),
        'conv_w': nrm((L, CONV_K, CONV_WIDTH), CONV_K ** -0.5),
        'conv_b': nrm((L, CONV_WIDTH), 0.01),
        'conv_ln_g': 1.0 + nrm((L, CONV_WIDTH), 0.01),
        'conv_ln_b': nrm((L, CONV_WIDTH), 0.01),
        'w_out': nrm((L, MIX_WIDTH, D), MIX_WIDTH ** -0.5),
        'router_w': nrm((D, N_EXPERTS), D ** -0.5),
        'router_bias': nrm((N_EXPERTS,), 0.01),
        'w_gate': nrm((L, N_EXPERTS, D, D_FF_EXPERT), D ** -0.5),
        'w_up': nrm((L, N_EXPERTS, D, D_FF_EXPERT), D ** -0.5),
        'w_down': nrm((L, N_EXPERTS, D_FF_EXPERT, D), D_FF_EXPERT ** -0.5),
        'g_final': 1.0 + nrm((D,), 0.01),
    }


def reference(x, c, ctx, c_ctx, w_mod, b_mod, g_mix, g_ffn, w_in, gla_wa_f, gla_ba_f, gla_wa_b, gla_ba_b,
              gla_g_norm, na_rpb, conv_w, conv_b, conv_ln_g, conv_ln_b, w_out, router_w, router_bias,
              w_gate, w_up, w_down, g_final):
    b, n, d = x.shape
    split_at = [int(s) for s in np.cumsum(IN_SIZES)[:-1]]
    cos, sin = axial_rope(n, GLA_DK)
    s_lat = jax.nn.silu(c)
    s_ctx = jax.nn.silu(c_ctx)[None]
    xc = ctx
    for l in range(DEPTH):
        last = l == DEPTH - 1
        mx = jnp.split((s_lat @ w_mod[l] + b_mod[l])[:, None, :], 6, axis=-1)
        mc = jnp.split((s_ctx @ w_mod[l] + b_mod[l])[:, None, :], 6, axis=-1)
        hx = rmsnorm(x, g_mix[l]) * (1 + mx[1]) + mx[0]
        hc = rmsnorm(xc, g_mix[l]) * (1 + mc[1]) + mc[0]
        px = jnp.split(hx @ w_in[l], split_at, axis=-1)
        pc = jnp.split(hc @ w_in[l], split_at, axis=-1)
        gw = (gla_wa_f[l], gla_ba_f[l], gla_wa_b[l], gla_ba_b[l])
        q_c, k_c, v_c, gf_c, gb_c = gla_inputs(pc[0], pc[1], pc[2], pc[4], *gw)
        q_x, k_x, v_x, gf_x, gb_x = gla_inputs(px[0], px[1], px[2], px[4], *gw)
        q_x, k_x = apply_rope(q_x, cos, sin), apply_rope(k_x, cos, sin)
        zero = jnp.zeros((b, GLA_HEADS, GLA_DK, GLA_DV), jnp.float32)
        o_gc, st_f, st_b = gla_bidir(q_c, k_c, v_c, gf_c, gb_c, zero, zero)
        o_gx, _, _ = gla_bidir(q_x, k_x, v_x, gf_x, gb_x, st_f, st_b)
        nq_x, nk_x, nv_x = na_heads(px[5], px[6], px[7])
        nq_c, nk_c, nv_c = na_heads(pc[5], pc[6], pc[7])
        o_nx = na_latent(nq_x, nk_x, nv_x, nk_c, nv_c, na_rpb[l])
        o_cx = conv_module(px[8], conv_w[l], conv_b[l], conv_ln_g[l], conv_ln_b[l])
        y_x = jnp.concatenate([gla_output(o_gx, px[3], gla_g_norm[l]), from_heads(o_nx), o_cx], axis=-1) @ w_out[l]
        x = x + mx[2] * y_x
        h2x = rmsnorm(x, g_ffn[l]) * (1 + mx[4]) + mx[3]
        if last:
            x = x + mx[5] * moe(h2x.reshape(b * n, d), router_w, router_bias,
                                w_gate[l], w_up[l], w_down[l]).reshape(b, n, d)
        else:
            o_nc = na_context(nq_c, nk_c, nv_c)
            o_cc = conv_module(pc[8], conv_w[l], conv_b[l], conv_ln_g[l], conv_ln_b[l])
            y_c = jnp.concatenate([gla_output(o_gc, pc[3], gla_g_norm[l]), from_heads(o_nc), o_cc], axis=-1) @ w_out[l]
            xc = xc + mc[2] * y_c
            h2c = rmsnorm(xc, g_ffn[l]) * (1 + mc[4]) + mc[3]
            lc = xc.shape[1]
            y = moe(jnp.concatenate([h2x.reshape(b * n, d), h2c.reshape(b * lc, d)], axis=0),
                    router_w, router_bias, w_gate[l], w_up[l], w_down[l])
            x = x + mx[5] * y[:b * n].reshape(b, n, d)
            xc = xc + mc[5] * y[b * n:].reshape(b, lc, d)
    return rmsnorm(x, g_final)
```

```cpp
#include <hip/hip_runtime.h>
#include <cstdio>
#include <cstdint>

#ifndef EN
#define EN 0xffff
#endif
#ifndef DUP
#define DUP 0
#endif
#ifndef MK_PER_PHASE
#define MK_PER_PHASE 0
#endif

#define GAS __attribute__((address_space(1)))
#define LAS __attribute__((address_space(3)))
typedef unsigned short bf16;
typedef float f32x4 __attribute__((ext_vector_type(4)));
typedef float f32x2 __attribute__((ext_vector_type(2)));
typedef short bf16x8 __attribute__((ext_vector_type(8)));
typedef short s16x4 __attribute__((ext_vector_type(4)));
typedef unsigned u32x4 __attribute__((ext_vector_type(4)));
typedef unsigned u32x2 __attribute__((ext_vector_type(2)));
typedef int i32x8 __attribute__((ext_vector_type(8)));
typedef int i32x4 __attribute__((ext_vector_type(4)));
typedef unsigned char fp8;

constexpr int D = 1024, NBATCH = 16, SEQ = 2048, CTXL = 256, DEPTH = 4;
constexpr int ML = NBATCH * SEQ, MC = NBATCH * CTXL, MT = ML + MC;
constexpr int NIN = 2848, NPX = 3072;
constexpr int C_GQ = 0, C_GK = 192, C_GV = 384, C_GG = 768, C_GA = 1152, C_NQ = 1184, C_NK = 1568, C_NV = 1952, C_CV = 2336, C_CG = 2592;
constexpr int NE = 16, NSLOT = 2 * MT;
constexpr int NCH = 36;
constexpr float EPS = 1e-6f;

constexpr size_t MiB = 1u << 20;
constexpr size_t WS_CTL = 0, CTL_ZERO_BYTES = 1 * MiB;
constexpr size_t WS_MOD = 1 * MiB;
constexpr size_t WS_ROPE = 3 * MiB;
constexpr size_t WS_DECAY = 4 * MiB;
constexpr size_t WS_WIN = 5 * MiB;
constexpr size_t WS_WOUT = 29 * MiB;
constexpr size_t WS_WGU = 37 * MiB;
constexpr size_t WS_XB = 165 * MiB;
constexpr size_t WS_RWP = 237 * MiB;
constexpr size_t WS_WD = 293 * MiB;
constexpr size_t WS_HX = 421 * MiB;
constexpr size_t WS_PX = 493 * MiB;
constexpr size_t WS_MIX = 709 * MiB;
constexpr size_t WS_GST = 781 * MiB;
constexpr size_t WS_XC = 862 * MiB;
constexpr size_t WS_LIST = 878 * MiB;
constexpr size_t WS_PV = 881 * MiB;
constexpr size_t WS_END = 936 * MiB;
constexpr int CW_TMO = 0, CW_BAR = 4096, CW_MOE = 8192, CW_SPL = 24576;

constexpr int SCR_BYTES = 139264;
constexpr int LDS_MISC = SCR_BYTES;
constexpr int LDS_PTR = LDS_MISC + 256;
constexpr int LDS_MOE = LDS_PTR + 256;
constexpr int LDS_ROWS = LDS_MOE + 256;
constexpr int MAXU = 12;
constexpr int LDS_BYTES = 152576;
static_assert(LDS_ROWS + MAXU * 1024 <= LDS_BYTES, "LDS map");

typedef __bf16 bf16x2_t __attribute__((ext_vector_type(2)));
__device__ __forceinline__ unsigned cvt_pk_bf16(float lo, float hi) { const bf16x2_t v = {(__bf16)lo, (__bf16)hi}; return __builtin_bit_cast(unsigned, v); }
__device__ __forceinline__ float bflo(unsigned w) { return __uint_as_float(w << 16); }
__device__ __forceinline__ float bfhi(unsigned w) { return __uint_as_float(w & 0xffff0000u); }
__device__ __forceinline__ f32x4 bf4(u32x2 w) { return (f32x4){bflo(w.x), bfhi(w.x), bflo(w.y), bfhi(w.y)}; }
__device__ __forceinline__ float bf2f(bf16 b) { return __uint_as_float((unsigned)b << 16); }
__device__ __forceinline__ float shx(float v, int o, int lane) { return __int_as_float(__builtin_amdgcn_ds_bpermute((lane ^ o) << 2, __float_as_int(v))); }
__device__ __forceinline__ float wave_sum(float v, int lane) {
#pragma unroll
    for (int o = 1; o < 64; o <<= 1) v += shx(v, o, lane);
    return v;
}
__device__ __forceinline__ f32x4 fp84(unsigned w) { const auto lo = __builtin_amdgcn_cvt_pk_f32_fp8((int)w, false); const auto hi = __builtin_amdgcn_cvt_pk_f32_fp8((int)w, true); return (f32x4){lo[0], lo[1], hi[0], hi[1]}; }
__device__ __forceinline__ unsigned pk4_fp8(float a, float b, float c, float d) { int p = __builtin_amdgcn_cvt_pk_fp8_f32(a, b, 0, false); p = __builtin_amdgcn_cvt_pk_fp8_f32(c, d, p, true); return (unsigned)p; }
__device__ __forceinline__ float silu_f(float x) { return x * __builtin_amdgcn_rcpf(1.0f + __expf(-x)); }
__device__ __forceinline__ float sigmoid_f(float x) { return __builtin_amdgcn_rcpf(1.0f + __expf(-x)); }

namespace pg8 {
constexpr int BM = 256, BK = 64, HALF = 128, HTB = HALF * BK * 2, STAGE_BYTES = 8 * HTB, NXCD = 8, WGM = 8;
__host__ __device__ __forceinline__ int lds_byte(int r, int c) { const int st = (r >> 4) * 2 + (c >> 5), rr = r & 15, cc = c & 31, ob = rr * 64 + cc * 2; return st * 1024 + (ob ^ (((ob >> 9) & 1) << 5)); }
__host__ __device__ __forceinline__ void stage_rc(int b, int& R, int& C) { const int st = b / 1024, sb = b % 1024, swz = sb ^ (((sb >> 9) & 1) << 5); R = (st >> 1) * 16 + swz / 64; C = (st & 1) * 32 + (swz % 64) / 2; }
__host__ __device__ __forceinline__ int perm32(int rho) { const int n = rho >> 4, i = rho & 15; return 8 * (i >> 2) + 4 * n + (i & 3); }

struct Unit { int pm, pn, aux; };
struct Gemm { const void* A; const void* Bt; int RB; int sclw; };

struct StaticOrder {
    int nM, nN, nwg, G, c;
    __device__ void init(int M, int N, int G_, int c_) { nM = M / BM; nN = N / BM; nwg = nM * nN; G = G_; c = c_; }
    __device__ bool next(int i, Unit& u) const {
        const long L = (long)i * G + c; if (L >= nwg) return false;
        int wgid = (int)L; { const int q = nwg / NXCD, r = nwg % NXCD, xcd = wgid % NXCD, off = wgid / NXCD; wgid = (xcd < r ? xcd * (q + 1) : r * (q + 1) + (xcd - r) * q) + off; }
        const int nig = WGM * nN, gid = wgid / nig, fm = gid * WGM, gsz = (nM - fm) < WGM ? (nM - fm) : WGM;
        u.pm = fm + ((wgid % nig) % gsz); u.pn = (wgid % nig) / gsz; u.aux = i; return true;
    }
    __device__ __forceinline__ unsigned row_off(const Unit&, int) const { return 0u; }
};

template <class Epi, class Sched, bool ALIGN_EPI, bool GATHER, bool FP8 = false>
__device__ __forceinline__ void gemm_phase(LAS unsigned char* lds, const Gemm g, const Sched& S, const Epi& E) {
    int tid_ = threadIdx.x; asm volatile("" : "+v"(tid_));
    const int tid = tid_, wid = __builtin_amdgcn_readfirstlane(tid >> 6), lane = tid & 63, wr = wid >> 2, wc = wid & 3, fr = lane & 15, fq = lane >> 4;
    const int RB = g.RB; int nt_ = RB / (BK * 2); asm volatile("" : "+s"(nt_)); const int nt = nt_;
    unsigned voffB[2];
#pragma unroll
    for (int i = 0; i < 2; ++i) { int R, C; stage_rc(tid * 16 + i * 8192, R, C); const int Rb = Epi::PERM ? ((R & ~31) + perm32(R & 31)) : R;
        voffB[i] = (unsigned)(Rb * RB + C * 2); }
    const size_t kstep = (size_t)(BK * 2);
    const size_t hstep = (size_t)HALF * RB;
    const size_t ahs = GATHER ? (size_t)0 : hstep;
    const size_t tstep = 2 * hstep;
    const unsigned ldsw = (unsigned)wid * 1024u;
    const int aoff = lds_byte(wr * 64 + fr, fq * 8), boff = lds_byte(wc * 32 + fr, fq * 8);
#define PG8_SA(b, h) (((b) * 2 + (h)) * HTB)
#define PG8_SB(b, h) ((4 + (b) * 2 + (h)) * HTB)
#define PG8_STAGE(bufoff, gbase, voff) do { _Pragma("unroll") for (int _i = 0; _i < 2; ++_i) \
        __builtin_amdgcn_global_load_lds((const unsigned*)((const char*)(gbase) + (voff)[_i]), (LAS unsigned*)(lds + (bufoff) + ldsw + _i * 8192), 16, 0, 0); } while (0)
#define PG8_LDA(dst, b, h) do { if constexpr (FP8) { _Pragma("unroll") for (int m = 0; m < 4; ++m) { const i32x4 _lo = *(const LAS i32x4*)(lds + PG8_SA(b, h) + aoff + m * 2048), _hi = *(const LAS i32x4*)(lds + PG8_SA(b, h) + aoff + m * 2048 + 1024); \
            dst##8[m] = __builtin_shufflevector(_lo, _hi, 0, 1, 2, 3, 4, 5, 6, 7); } } \
        else { _Pragma("unroll") for (int m = 0; m < 4; ++m) _Pragma("unroll") for (int k = 0; k < 2; ++k) dst[m][k] = *(const LAS bf16x8*)(lds + PG8_SA(b, h) + aoff + m * 2048 + k * 1024); } } while (0)
#define PG8_LDB(dst, b, h) do { if constexpr (FP8) { _Pragma("unroll") for (int n = 0; n < 2; ++n) { const i32x4 _lo = *(const LAS i32x4*)(lds + PG8_SB(b, h) + boff + n * 2048), _hi = *(const LAS i32x4*)(lds + PG8_SB(b, h) + boff + n * 2048 + 1024); \
            dst##8[n] = __builtin_shufflevector(_lo, _hi, 0, 1, 2, 3, 4, 5, 6, 7); } } \
        else { _Pragma("unroll") for (int n = 0; n < 2; ++n) _Pragma("unroll") for (int k = 0; k < 2; ++k) dst[n][k] = *(const LAS bf16x8*)(lds + PG8_SB(b, h) + boff + n * 2048 + k * 1024); } } while (0)
#define PG8_MMA(ai, bj, At, Bt) do { __builtin_amdgcn_s_setprio(1); _Pragma("unroll") for (int m = 0; m < 4; ++m) _Pragma("unroll") for (int n = 0; n < 2; ++n) { \
        if constexpr (FP8) asm volatile("v_mfma_scale_f32_16x16x128_f8f6f4 %0, %1, %2, %0, %3, %4 op_sel_hi:[0,0,0]" : "+v"(acc[ai][bj][m][n]) : "v"(Bt##8[n]), "v"(At##8[m]), "v"(sclw), "v"(scl1));   \
        else { _Pragma("unroll") for (int k = 0; k < 2; ++k) acc[ai][bj][m][n] = __builtin_amdgcn_mfma_f32_16x16x32_bf16(Bt[n][k], At[m][k], acc[ai][bj][m][n], 0, 0, 0); } } \
        __builtin_amdgcn_s_setprio(0); } while (0)
#define PG8_WAIT_V(n) asm volatile("s_waitcnt vmcnt(" #n ")" ::: "memory")
#define PG8_WAIT_L(n) asm volatile("s_waitcnt lgkmcnt(" #n ")" ::: "memory")
#define PG8_BAR __builtin_amdgcn_s_barrier()
#define PG8_SCHED __builtin_amdgcn_sched_barrier(0)
#define PG8_SETVA(v, u) do { _Pragma("unroll") for (int _i = 0; _i < 2; ++_i) { int _R, _C; stage_rc(tid * 16 + _i * 8192, _R, _C); \
        if constexpr (GATHER) { v[0][_i] = S.row_off(u, _R) + (unsigned)_C * 2u; v[1][_i] = S.row_off(u, HALF + _R) + (unsigned)_C * 2u; } \
        else { v[0][_i] = (unsigned)(_R * RB + _C * 2); v[1][_i] = v[0][_i]; } } } while (0)
    Unit cur, nxt; int ui = 0;
    if (!S.next(0, cur)) return;
    f32x4 acc[2][2][4][2];
#pragma unroll
    for (int a = 0; a < 2; ++a)
#pragma unroll
        for (int b = 0; b < 2; ++b)
#pragma unroll
            for (int m = 0; m < 4; ++m)
#pragma unroll
                for (int n = 0; n < 2; ++n) acc[a][b][m][n] = (f32x4){0.f, 0.f, 0.f, 0.f};
    const int scl1 = 0x7f7f7f7f; const int sclw = g.sclw;
    bf16x8 At[4][2], B0[2][2], B1[2][2]; i32x8 At8[4], B08[2], B18[2];
    unsigned vA[2][2], vAn[2][2];
    PG8_SETVA(vA, cur);
    const char* cA = GATHER ? (const char*)g.A : (const char*)g.A + (size_t)cur.pm * tstep; const char* cB = (const char*)g.Bt + (size_t)cur.pn * tstep;
    PG8_STAGE(PG8_SB(0, 0), cB, voffB); PG8_STAGE(PG8_SB(0, 1), cB + hstep, voffB); PG8_STAGE(PG8_SA(0, 0), cA, vA[0]); PG8_STAGE(PG8_SA(0, 1), cA + ahs, vA[1]);
    if (wr == 1) PG8_BAR;
    PG8_WAIT_V(2); PG8_BAR;
    PG8_STAGE(PG8_SB(1, 0), cB + kstep, voffB); PG8_STAGE(PG8_SA(1, 0), cA + kstep, vA[0]); PG8_STAGE(PG8_SB(1, 1), cB + hstep + kstep, voffB);
    PG8_WAIT_V(6); PG8_BAR;
    for (;;) {
        const bool has_next = S.next(ui + 1, nxt);
        const char* nA = GATHER ? cA : (has_next ? (const char*)g.A + (size_t)nxt.pm * tstep : cA);
        const char* nB = has_next ? (const char*)g.Bt + (size_t)nxt.pn * tstep : cB;
        if constexpr (GATHER) {
            if (has_next) { PG8_SETVA(vAn, nxt); }
            else {
#pragma unroll
                for (int h = 0; h < 2; ++h)
#pragma unroll
                    for (int i = 0; i < 2; ++i) vAn[h][i] = vA[h][i]; }
        }
#pragma unroll 1
        for (int t = 0; t < nt; t += 2) {
            const bool last = (t == nt - 2);
            const char* a1 = cA + (size_t)(t + 1) * kstep;
            const char* a2 = last ? nA : cA + (size_t)(t + 2) * kstep; const char* b2 = last ? nB : cB + (size_t)(t + 2) * kstep;
            const char* a3 = a2 + kstep; const char* b3 = b2 + kstep;
            unsigned v2[2][2];
#pragma unroll
            for (int h = 0; h < 2; ++h)
#pragma unroll
                for (int i = 0; i < 2; ++i) { if constexpr (GATHER) v2[h][i] = last ? vAn[h][i] : vA[h][i]; else v2[h][i] = vA[h][i]; }
            PG8_LDB(B0, 0, 0); PG8_LDB(B1, 0, 1); PG8_SCHED; PG8_LDA(At, 0, 0); PG8_STAGE(PG8_SA(1, 1), a1 + ahs, vA[1]);
            PG8_WAIT_V(8); PG8_WAIT_L(0); PG8_BAR; PG8_MMA(0, 0, At, B0); PG8_MMA(0, 1, At, B1); PG8_BAR; PG8_SCHED;
            PG8_LDA(At, 0, 1); PG8_STAGE(PG8_SB(0, 0), b2, voffB); PG8_STAGE(PG8_SB(0, 1), b2 + hstep, voffB); PG8_STAGE(PG8_SA(0, 0), a2, v2[0]);
            PG8_WAIT_V(8); PG8_WAIT_L(0); PG8_BAR; PG8_MMA(1, 0, At, B0); PG8_MMA(1, 1, At, B1); PG8_BAR; PG8_SCHED;
            PG8_LDB(B0, 1, 0); PG8_LDB(B1, 1, 1); PG8_SCHED; PG8_LDA(At, 1, 0); PG8_STAGE(PG8_SA(0, 1), a2 + ahs, v2[1]);
            PG8_WAIT_V(8); PG8_WAIT_L(0); PG8_BAR; PG8_MMA(0, 0, At, B0); PG8_MMA(0, 1, At, B1); PG8_BAR; PG8_SCHED;
            PG8_LDA(At, 1, 1); PG8_STAGE(PG8_SB(1, 0), b3, voffB); PG8_STAGE(PG8_SB(1, 1), b3 + hstep, voffB); PG8_STAGE(PG8_SA(1, 0), a3, v2[0]);
            PG8_WAIT_V(8); PG8_WAIT_L(0); PG8_BAR; PG8_MMA(1, 0, At, B0); PG8_MMA(1, 1, At, B1); PG8_BAR; PG8_SCHED;
        }
        if constexpr (ALIGN_EPI) { if (wr == 0) PG8_BAR; }
        if constexpr (FP8) asm volatile("s_nop 15\n\ts_nop 15" ::: "memory");
        E(acc, cur, wr, wc, fr, fq);
        if (!has_next) break;
#pragma unroll
        for (int a = 0; a < 2; ++a)
#pragma unroll
            for (int b = 0; b < 2; ++b)
#pragma unroll
                for (int m = 0; m < 4; ++m)
#pragma unroll
                    for (int n = 0; n < 2; ++n) acc[a][b][m][n] = (f32x4){0.f, 0.f, 0.f, 0.f};
        cur = nxt; cA = nA; cB = nB; ++ui;
        if constexpr (GATHER) {
#pragma unroll
            for (int h = 0; h < 2; ++h)
#pragma unroll
                for (int i = 0; i < 2; ++i) vA[h][i] = vAn[h][i]; }
        if constexpr (ALIGN_EPI) { if (wr == 1) PG8_BAR; }
    }
    PG8_WAIT_V(0);
    if constexpr (!ALIGN_EPI) { if (wr == 0) PG8_BAR; }
    PG8_BAR;
#undef PG8_SA
#undef PG8_SB
#undef PG8_STAGE
#undef PG8_LDA
#undef PG8_LDB
#undef PG8_MMA
#undef PG8_WAIT_V
#undef PG8_WAIT_L
#undef PG8_BAR
#undef PG8_SCHED
#undef PG8_SETVA
}
}

#define XB_TMO      128
#define XB_XCNT(j)  (256  + 64 * (j))
#define XB_XSUB(j)  (1280 + 64 * (j))
#define XB_XGEN(j)  (2304 + 64 * (j))
#define XB_TOP      3328
#define XB_TOPGEN   3392
#define XCD_BAR_WORDS 3456
#define XB_SPIN_CAP (1u << 18)
__device__ __forceinline__ unsigned xb_ld(unsigned* p)              { return __hip_atomic_load(p, __ATOMIC_RELAXED, __HIP_MEMORY_SCOPE_AGENT); }
__device__ __forceinline__ unsigned xb_add(unsigned* p, unsigned v) { return __hip_atomic_fetch_add(p, v, __ATOMIC_RELAXED, __HIP_MEMORY_SCOPE_AGENT); }
__device__ __forceinline__ unsigned xb_xcc_id() { return (unsigned)__builtin_amdgcn_s_getreg((3 << 11) | 20) & 0xFu; }
#define XB_SPIN(cond, bar) do { unsigned _sp = 0; while (cond) { __builtin_amdgcn_s_sleep(1); \
    if ((++_sp & 255u) == 0u) { if (xb_ld(&(bar)[XB_TMO])) break; if (_sp > XB_SPIN_CAP) { atomicAdd(&(bar)[XB_TMO], 1u); break; } } } } while (0)
struct XcdBarrier { unsigned* bar; unsigned x; volatile LAS unsigned* st; };
__device__ __forceinline__ XcdBarrier xcd_barrier_post(unsigned* bar, volatile LAS unsigned* st) {
    XcdBarrier b; b.bar = bar; b.x = xb_xcc_id(); b.st = st;
    if (threadIdx.x == 0) (void)xb_add(&bar[XB_XCNT(b.x)], 1u);
    return b;
}
__device__ __forceinline__ void xcd_barrier_complete(unsigned* bar, unsigned x, unsigned& nloc, unsigned& nx) {
    const unsigned G = gridDim.x * gridDim.y * gridDim.z;
    unsigned sum, cnt, mine, sp = 0u;
    for (;;) {
        sum = 0u; cnt = 0u; mine = 0u;
#pragma unroll
        for (unsigned j = 0; j < 16; ++j) { const unsigned c = xb_ld(&bar[XB_XCNT(j)]); sum += c; cnt += (c > 0u) ? 1u : 0u; mine = (j == x) ? c : mine; }
        if (sum == G) break;
        __builtin_amdgcn_s_sleep(1);
        if ((++sp & 255u) == 0u) { if (xb_ld(&bar[XB_TMO])) break; if (sp > XB_SPIN_CAP) { atomicAdd(&bar[XB_TMO], 1u); break; } }
    }
    nloc = mine > 0u ? mine : 1u; nx = cnt > 0u ? cnt : 1u;
}
__device__ __forceinline__ void xcd_barrier(const XcdBarrier& b) {
    asm volatile("s_waitcnt vmcnt(0)" ::: "memory");
    __syncthreads();
    if (threadIdx.x == 0) {
        unsigned* bar = b.bar;
        __builtin_amdgcn_s_waitcnt(0);
        unsigned nloc = b.st[0], nx = b.st[1];
        if (nloc == 0u) { xcd_barrier_complete(bar, b.x, nloc, nx); b.st[0] = nloc; b.st[1] = nx; }
        const unsigned old = xb_add(&bar[XB_XSUB(b.x)], 1u);
        const unsigned gen = old / nloc;
        if (old + 1u == (gen + 1u) * nloc) {
            __builtin_amdgcn_fence(__ATOMIC_RELEASE, "agent");
            asm volatile("s_waitcnt vmcnt(0)" ::: "memory");
            const unsigned og = xb_add(&bar[XB_TOP], 1u);
            const unsigned tg = og / nx;
            if (og + 1u == (tg + 1u) * nx) xb_add(&bar[XB_TOPGEN], 1u);
            else XB_SPIN(xb_ld(&bar[XB_TOPGEN]) == tg, bar);
            __builtin_amdgcn_fence(__ATOMIC_ACQUIRE, "agent");
            xb_add(&bar[XB_XGEN(b.x)], 1u);
            asm volatile("s_waitcnt vmcnt(0)" ::: "memory");
        } else {
            XB_SPIN(xb_ld(&bar[XB_XGEN(b.x)]) == gen, bar);
            __builtin_amdgcn_fence(__ATOMIC_ACQUIRE, "agent");
            asm volatile("s_waitcnt vmcnt(0)" ::: "memory");
        }
    }
    __syncthreads();
}
__device__ __forceinline__ void xcd_arrive(const XcdBarrier& b, unsigned* slot) {
    asm volatile("s_waitcnt vmcnt(0)" ::: "memory");
    __syncthreads();
    if (threadIdx.x == 0) {
        __builtin_amdgcn_s_waitcnt(0);
        const unsigned nloc = b.st[0];
        const unsigned old = xb_add(&slot[64 * b.x], 1u);
        if (old + 1u == nloc) {
            __builtin_amdgcn_fence(__ATOMIC_RELEASE, "agent");
            asm volatile("s_waitcnt vmcnt(0)" ::: "memory");
            xb_add(&slot[1024], 1u);
        }
    }
}
__device__ __forceinline__ void xcd_wait(const XcdBarrier& b, unsigned* slot) {
    if (threadIdx.x == 0) {
        const unsigned nx = b.st[1];
        XB_SPIN(xb_ld(&slot[1024]) < nx, b.bar);
        __builtin_amdgcn_fence(__ATOMIC_ACQUIRE, "agent");
        asm volatile("s_waitcnt vmcnt(0)" ::: "memory");
    }
    __syncthreads();
}

struct Frame {
    LAS unsigned char* lds;
    int tid, lane, wave, G, bid;
    float* out;
    unsigned char* ws;
};
__device__ __forceinline__ const float* inptr(const Frame& F, int k) {
    const LAS unsigned* t = (const LAS unsigned*)(F.lds + LDS_PTR) + 2 * k;
    const unsigned lo = __builtin_amdgcn_readfirstlane(t[0]), hi = __builtin_amdgcn_readfirstlane(t[1]);
    return (const float*)(const GAS float*)(((unsigned long long)hi << 32) | lo);
}
#define WSP(T, off) ((T*)(F.ws + (off)))
#define F_CTL WSP(unsigned, WS_CTL)
#define F_MOD WSP(float, WS_MOD)
#define F_ROPE WSP(float, WS_ROPE)
#define F_DECAY WSP(float, WS_DECAY)
#define F_WIN WSP(fp8, WS_WIN)
#define F_WOUT WSP(fp8, WS_WOUT)
#define F_WGU WSP(fp8, WS_WGU)
#define F_WD WSP(fp8, WS_WD)
#define F_HX WSP(bf16, WS_HX)
#define F_PX WSP(bf16, WS_PX)
#define F_ACT WSP(fp8, WS_PX)
#define F_HX8 WSP(fp8, WS_HX)
#define F_MIX WSP(fp8, WS_MIX)
#define F_YBUF WSP(fp8, WS_MIX)
#define F_PV WSP(float, WS_PV)
#define F_GST WSP(bf16, WS_GST)
#define F_XB WSP(bf16, WS_XB)
#define F_RWH WSP(bf16, WS_RWP)
#define F_RWL WSP(bf16, WS_RWP + 1 * MiB)
#define F_CB WSP(float, WS_RWP + 2 * MiB)
#define F_KNL WSP(bf16, WS_RWP + 8 * MiB)
#define F_VNL WSP(bf16, WS_RWP + 32 * MiB)
#define F_KNC WSP(bf16, WS_GST + 41 * MiB)
#define F_VNC WSP(bf16, WS_GST + 44 * MiB)
#define F_AF WSP(float, WS_RWP + 3 * MiB)
#define F_BF WSP(float, WS_RWP + 4 * MiB)
#define F_LIST WSP(int, WS_LIST)
#define F_SLOTW WSP(float, WS_LIST + 2 * MiB + 512 * 1024)
#define F_SPOS WSP(int, WS_XC)

struct EpiPx {
    static constexpr bool PERM = true;
    bf16* O; unsigned char* ws;
    __device__ __forceinline__ void operator()(const f32x4 (&acc)[2][2][4][2], const pg8::Unit& u, int wr, int wc, int fr, int fq) const {
        const int t0 = u.pm * 256, row0 = t0 + wr * 64 + fr, col0 = u.pn * 256 + wc * 32 + 8 * fq;
        const bool lat = t0 < ML; const int b = lat ? (t0 >> 11) : ((t0 - ML) >> 8); const int tb = lat ? b * 2048 : ML + b * 256;
#pragma unroll
        for (int bj = 0; bj < 2; ++bj) {
            const int cw = u.pn * 256 + bj * 128 + wc * 32;
            bf16* base; size_t rstride;
            if (cw >= C_NK && cw < C_CV) { const bool isv = cw >= C_NV; const int cc = cw - (isv ? C_NV : C_NK), h = cc >> 6, d0 = (cc & 63) + 8 * fq;
                const size_t off = lat ? (isv ? WS_RWP + 32 * MiB : WS_RWP + 8 * MiB) : (isv ? WS_GST + 44 * MiB : WS_GST + 41 * MiB);
                base = (bf16*)(ws + off) + (size_t)(b * 6 + h) * (lat ? 2048 * 64 : 256 * 64) + (size_t)(row0 - tb) * 64 + d0; rstride = 64; }
            else { base = O + (size_t)row0 * NPX + col0 + bj * 128; rstride = NPX; }
#pragma unroll
            for (int ai = 0; ai < 2; ++ai)
#pragma unroll
                for (int m = 0; m < 4; ++m) { const f32x4 v0 = acc[ai][bj][m][0], v1 = acc[ai][bj][m][1];
                    u32x4 w; w.x = cvt_pk_bf16(v0[0], v0[1]); w.y = cvt_pk_bf16(v0[2], v0[3]); w.z = cvt_pk_bf16(v1[0], v1[1]); w.w = cvt_pk_bf16(v1[2], v1[3]);
                    *(u32x4*)(base + (size_t)(ai * 128 + m * 16) * rstride) = w; }
        }
    }
};
template <bool L0>
struct EpiResid {
    static constexpr bool PERM = true;
    const float* lat_in; const float* ctx_in; bf16* xb; const float* modl;
    __device__ __forceinline__ void operator()(const f32x4 (&acc)[2][2][4][2], const pg8::Unit& u, int wr, int wc, int fr, int fq) const {
        const int t0 = u.pm * 256; const bool lat = t0 < ML; const int b = lat ? (t0 >> 11) : 16;
        const float* base = lat ? lat_in + (size_t)t0 * D : ctx_in + (size_t)(t0 - ML) * D;
        const int col0 = u.pn * 256 + wc * 32 + 8 * fq;
        const float* gate = modl + (size_t)b * 6144 + 2 * 1024 + col0;
        f32x4 gv[2][2];
#pragma unroll
        for (int bj = 0; bj < 2; ++bj)
#pragma unroll
            for (int n = 0; n < 2; ++n) gv[bj][n] = *(const f32x4*)(gate + bj * 128 + 4 * n);
#pragma unroll
        for (int ai = 0; ai < 2; ++ai)
#pragma unroll
            for (int m = 0; m < 4; ++m) { const int rr = ai * 128 + wr * 64 + m * 16 + fr; bf16* op = xb + (size_t)(t0 + rr) * D + col0;
#pragma unroll
                for (int bj = 0; bj < 2; ++bj) { f32x4 b0, b1;
                    if constexpr (L0) { b0 = *(const f32x4*)(base + (size_t)rr * D + col0 + bj * 128); b1 = *(const f32x4*)(base + (size_t)rr * D + col0 + bj * 128 + 4); }
                    else { const u32x4 w = *(const u32x4*)(op + bj * 128); b0 = (f32x4){bflo(w.x), bfhi(w.x), bflo(w.y), bfhi(w.y)}; b1 = (f32x4){bflo(w.z), bfhi(w.z), bflo(w.w), bfhi(w.w)}; }
                    const f32x4 v0 = b0 + gv[bj][0] * acc[ai][bj][m][0], v1 = b1 + gv[bj][1] * acc[ai][bj][m][1];
                    u32x4 o; o.x = cvt_pk_bf16(v0[0], v0[1]); o.y = cvt_pk_bf16(v0[2], v0[3]); o.z = cvt_pk_bf16(v1[0], v1[1]); o.w = cvt_pk_bf16(v1[2], v1[3]);
                    *(u32x4*)(op + bj * 128) = o; } }
    }
};
struct EpiSwiGLU {
    static constexpr bool PERM = true;
    fp8* act;
    __device__ __forceinline__ void operator()(const f32x4 (&acc)[2][2][4][2], const pg8::Unit& u, int wr, int wc, int fr, int fq) const {
        const int row0 = u.pm * 256 + wr * 64 + fr, col0 = (u.pn & 7) * 128 + wc * 32 + 8 * fq;
#pragma unroll
        for (int ai = 0; ai < 2; ++ai)
#pragma unroll
            for (int m = 0; m < 4; ++m) { fp8* rowp = act + (size_t)(row0 + ai * 128 + m * 16) * 1024 + col0;
                f32x4 r4[2];
#pragma unroll
                for (int n = 0; n < 2; ++n) { const f32x4 ag = acc[ai][0][m][n], au = acc[ai][1][m][n]; const f32x4 t = ag * (-1.4426950408889634f);
                    f32x4 e; e[0] = __builtin_amdgcn_exp2f(t[0]); e[1] = __builtin_amdgcn_exp2f(t[1]); e[2] = __builtin_amdgcn_exp2f(t[2]); e[3] = __builtin_amdgcn_exp2f(t[3]);
                    const f32x4 d = e + 1.0f;
                    f32x4 rc; rc[0] = __builtin_amdgcn_rcpf(d[0]); rc[1] = __builtin_amdgcn_rcpf(d[1]); rc[2] = __builtin_amdgcn_rcpf(d[2]); rc[3] = __builtin_amdgcn_rcpf(d[3]);
                    r4[n] = (ag * au) * rc; }
                u32x2 w; w.x = pk4_fp8(r4[0][0], r4[0][1], r4[0][2], r4[0][3]); w.y = pk4_fp8(r4[1][0], r4[1][1], r4[1][2], r4[1][3]);
                *(u32x2*)rowp = w; }
    }
};
struct EpiYrow {
    static constexpr bool PERM = true;
    fp8* yrow;
    __device__ __forceinline__ void operator()(const f32x4 (&acc)[2][2][4][2], const pg8::Unit& u, int wr, int wc, int fr, int fq) const {
        const int row0 = u.pm * 256 + wr * 64 + fr, col0 = (u.pn & 3) * 256 + wc * 32 + 8 * fq;
#pragma unroll
        for (int ai = 0; ai < 2; ++ai)
#pragma unroll
            for (int m = 0; m < 4; ++m) { fp8* rowp = yrow + (size_t)(row0 + ai * 128 + m * 16) * 1024 + col0;
#pragma unroll
                for (int bj = 0; bj < 2; ++bj) { const f32x4 v0 = acc[ai][bj][m][0], v1 = acc[ai][bj][m][1];
                    u32x2 w; w.x = pk4_fp8(v0[0], v0[1], v0[2], v0[3]); w.y = pk4_fp8(v1[0], v1[1], v1[2], v1[3]);
                    *(u32x2*)(rowp + bj * 128) = w; } }
    }
};

struct SplitOrder {
    pg8::StaticOrder base; int i0, i1;
    __device__ __forceinline__ bool next(int i, pg8::Unit& u) const { return (i0 + i < i1) && base.next(i0 + i, u); }
    __device__ __forceinline__ unsigned row_off(const pg8::Unit&, int) const { return 0u; }
};
struct MoeOrder {
    const LAS int* mbase; const LAS int* rows; int NT, G, c, TM; unsigned rowbytes;
    __device__ __forceinline__ bool next(int i, pg8::Unit& u) const {
        int pnl, gm;
        if ((G & 7) == 0) { const int xcd = c & 7, j = c >> 3, q = i * (G >> 3) + j; pnl = q % NT; gm = (q / NT) * 8 + xcd; }
        else { const int L = i * G + c; pnl = L % NT; gm = L / NT; }
        if (gm >= TM) return false;
        int e = 0;
#pragma unroll
        for (int k = 1; k < 16; ++k) e += (mbase[k] <= gm) ? 1 : 0;
        u.pm = gm; u.pn = __builtin_amdgcn_readfirstlane(e) * NT + pnl; u.aux = i; return true;
    }
    __device__ __forceinline__ unsigned row_off(const pg8::Unit& u, int r) const { const int s = rows[u.aux * 256 + r]; return s < 0 ? 0u : (unsigned)(s >> 1) * rowbytes; }
};

__device__ __forceinline__ void transpose_item(const float* W, int ldw, int k0, int n0, bf16* WT, int Kd, int drow0, LAS float* scr, int lane) {
#pragma unroll 8
    for (int i = 0; i < 32; ++i) { const int kk = 2 * i + (lane >> 5); scr[kk * 33 + (lane & 31)] = W[(size_t)(k0 + kk) * ldw + n0 + (lane & 31)]; }
    asm volatile("s_waitcnt lgkmcnt(0)" ::: "memory");
    const int c = lane & 7;
#pragma unroll
    for (int j = 0; j < 4; ++j) { const int n = (lane >> 3) + 8 * j; const LAS float* s = scr + (8 * c) * 33 + n;
        u32x4 o; o.x = cvt_pk_bf16(s[0 * 33], s[1 * 33]); o.y = cvt_pk_bf16(s[2 * 33], s[3 * 33]); o.z = cvt_pk_bf16(s[4 * 33], s[5 * 33]); o.w = cvt_pk_bf16(s[6 * 33], s[7 * 33]);
        *(u32x4*)(WT + (size_t)(drow0 + n) * Kd + k0 + 8 * c) = o; }
    asm volatile("s_waitcnt lgkmcnt(0)" ::: "memory");
}
__device__ __forceinline__ void transpose_item_fp8(const float* W, int ldw, int k0, int n0, fp8* WT, int Kd, int drow0, LAS float* scr, int lane) {
    float wv[32];
#pragma unroll
    for (int i = 0; i < 32; ++i) { const int kk = 2 * i + (lane >> 5); wv[i] = W[(size_t)(k0 + kk) * ldw + n0 + (lane & 31)]; }
#pragma unroll
    for (int i = 0; i < 32; ++i) { const int kk = 2 * i + (lane >> 5); scr[kk * 33 + (lane & 31)] = wv[i] * 64.0f; }
    asm volatile("s_waitcnt lgkmcnt(0)" ::: "memory");
    const int c = lane & 3;
#pragma unroll
    for (int j = 0; j < 2; ++j) { const int n = (lane >> 2) + 16 * j; const LAS float* s = scr + (16 * c) * 33 + n;
        u32x4 o; o.x = pk4_fp8(s[0 * 33], s[1 * 33], s[2 * 33], s[3 * 33]); o.y = pk4_fp8(s[4 * 33], s[5 * 33], s[6 * 33], s[7 * 33]);
        o.z = pk4_fp8(s[8 * 33], s[9 * 33], s[10 * 33], s[11 * 33]); o.w = pk4_fp8(s[12 * 33], s[13 * 33], s[14 * 33], s[15 * 33]);
        *(u32x4*)(WT + (size_t)(drow0 + n) * Kd + k0 + 16 * c) = o; }
    asm volatile("s_waitcnt lgkmcnt(0)" ::: "memory");
}
__device__ __forceinline__ void moe_convert(const Frame& F, int l, int first, int stride) {
    LAS float* T = (LAS float*)F.lds;
    const int tid = F.tid;
    constexpr int NIT = NE * 3 * 32;
    f32x4 v[16];
#define MC_LOAD(it0) do { const int _it = l * NIT + (it0); const int _le = _it / 96, _q = _it % 96, _which = _q / 32, _kb = (_q % 32) >> 2, _nb = _q & 3; \
        const float* _W = inptr(F, _which == 0 ? 22 : (_which == 1 ? 23 : 24)) + (size_t)_le * D * D + (size_t)(128 * _kb) * D + 256 * _nb; \
        _Pragma("unroll") for (int i = 0; i < 16; ++i) { const int idx = tid + 512 * i, kk = idx >> 6, c4 = idx & 63; v[i] = *(const f32x4*)(_W + (size_t)kk * D + 4 * c4); } } while (0)
    if (first < NIT) MC_LOAD(first);
    for (int it0 = first; it0 < NIT; it0 += stride) {
        const int it = l * NIT + it0;
        const int le = it / 96, q = it % 96, which = q / 32, kb = (q % 32) >> 2, nb = q & 3, k0 = 128 * kb, n0 = 256 * nb;
#pragma unroll
        for (int i = 0; i < 16; ++i) { const int idx = tid + 512 * i, kk = idx >> 6, c4 = idx & 63; *(LAS f32x4*)(T + kk * 260 + 4 * c4) = v[i] * 64.0f; }
        if (it0 + stride < NIT) MC_LOAD(it0 + stride);
        __syncthreads();
        fp8* WT = (which == 2) ? F_WD + (size_t)le * D * D : F_WGU + (size_t)le * 2048 * D;
#pragma unroll
        for (int i = 0; i < 4; ++i) { const int idx = tid + 512 * i, n = idx & 255, c = idx >> 8;
            const LAS float* s = T + (16 * c) * 260 + n;
            u32x4 o; o.x = pk4_fp8(s[0 * 260], s[1 * 260], s[2 * 260], s[3 * 260]); o.y = pk4_fp8(s[4 * 260], s[5 * 260], s[6 * 260], s[7 * 260]);
            o.z = pk4_fp8(s[8 * 260], s[9 * 260], s[10 * 260], s[11 * 260]); o.w = pk4_fp8(s[12 * 260], s[13 * 260], s[14 * 260], s[15 * 260]);
            const int nn = n0 + n; const int drow = (which == 2) ? nn : ((nn >> 7) * 256 + (which == 1 ? 128 : 0) + (nn & 127));
            *(u32x4*)(WT + (size_t)drow * D + k0 + 16 * c) = o; }
        __syncthreads();
    }
#undef MC_LOAD
}
__device__ __forceinline__ void phase_prologue(const Frame& F) {
    const int gw = F.bid * 8 + F.wave, NGW = F.G * 8, lane = F.lane;
    auto part_a = [&]() {
        LAS float* scr = (LAS float*)(F.lds + F.wave * 16384);
        constexpr int I_IN = 16 * 89, I_OUT = 512, I_E = 512;
        constexpr int N_IN = DEPTH * I_IN, N_OUT = DEPTH * I_OUT, N_MOE = DEPTH * NE * 3 * I_E;
        for (int it = gw; it < N_IN + N_OUT; it += NGW) {
            int r = it;
            if (r < N_IN) { const int l = r / I_IN, q = r % I_IN, kb = q / 89, nb = q % 89;
                transpose_item_fp8(inptr(F, 8) + (size_t)l * D * NIN, NIN, 64 * kb, 32 * nb, F_WIN + (size_t)l * NPX * D, D, 32 * nb, scr, lane); continue; }
            r -= N_IN;
            if (r < N_OUT) { const int l = r / I_OUT, q = r % I_OUT, kb = q / 32, nb = q % 32;
                transpose_item_fp8(inptr(F, 19) + (size_t)l * D * D, D, 64 * kb, 32 * nb, F_WOUT + (size_t)l * D * D, D, 32 * nb, scr, lane); continue; }
        }
        for (int i = F.bid * 512 + F.tid; i < DEPTH * (NPX - NIN) * (D / 16); i += F.G * 512) { const int l = i / ((NPX - NIN) * (D / 16)), q = i % ((NPX - NIN) * (D / 16));
            *(u32x4*)(F_WIN + (size_t)l * NPX * D + (size_t)NIN * D + (size_t)q * 16) = (u32x4){0u, 0u, 0u, 0u}; }
        __syncthreads();
    };
    auto part_c = [&]() {
    if (F.bid == 0) { for (int i = F.tid; i < 64 * 12; i += 512) { const int p = i / 12, j = i % 12; const float inv = powf(10000.0f, -(float)(2 * j) / 24.0f); float sn, cs; sincosf((float)p * inv, &sn, &cs); F_ROPE[2 * i] = cs; F_ROPE[2 * i + 1] = sn; } }
    {
        LAS float* sL = (LAS float*)F.lds;
        LAS float* red = (LAS float*)(F.lds + 17 * 1024 * 4);
        for (int i = F.tid; i < 17 * 1024; i += 512) { const int r = i >> 10, k = i & 1023; const float v = r < 16 ? inptr(F, 1)[r * 1024 + k] : inptr(F, 3)[k]; sL[i] = v / (1.0f + expf(-v)); }
        __syncthreads();
        for (int u = F.bid; u < DEPTH * 96; u += F.G) {
            const int l = u / 96, n0 = (u % 96) * 64;
            const float* W = inptr(F, 4) + (size_t)l * D * 6144 + n0 + lane;
            float acc[17];
#pragma unroll
            for (int r = 0; r < 17; ++r) acc[r] = 0.f;
            const int kb = F.wave * 128;
            for (int k0 = 0; k0 < 128; k0 += 32) { float wv[32];
#pragma unroll
                for (int k = 0; k < 32; ++k) wv[k] = W[(size_t)(kb + k0 + k) * 6144];
#pragma unroll
                for (int k = 0; k < 32; ++k)
#pragma unroll
                    for (int r = 0; r < 17; ++r) acc[r] += sL[r * 1024 + kb + k0 + k] * wv[k]; }
#pragma unroll
            for (int r = 0; r < 17; ++r) red[(F.wave * 17 + r) * 64 + lane] = acc[r];
            __syncthreads();
            for (int i = F.tid; i < 17 * 64; i += 512) { const int r = i >> 6, nn = i & 63; float s = inptr(F, 5)[l * 6144 + n0 + nn];
#pragma unroll
                for (int w = 0; w < 8; ++w) s += red[(w * 17 + r) * 64 + nn];
                F_MOD[((size_t)l * 17 + r) * 6144 + n0 + nn] = s; }
            __syncthreads();
        }
    }
    };
    if (F.bid & 1) { part_a(); part_c(); } else { part_c(); part_a(); }
}

__device__ __forceinline__ void moe_tilebase_to_lds(const Frame& F, int lm) {
    LAS int* tab = (LAS int*)(F.lds + LDS_MOE);
    if (F.tid < 16) tab[F.tid] = (int)__hip_atomic_load(F_CTL + CW_MOE + (lm * 16 + F.tid) * 64, __ATOMIC_RELAXED, __HIP_MEMORY_SCOPE_AGENT);
    __syncthreads();
    if (F.tid == 0) { int acc = 0;
#pragma unroll
        for (int e = 0; e < 16; ++e) { tab[16 + e] = acc; acc += (tab[e] + 255) >> 8; } }
    __syncthreads();
}
__device__ __forceinline__ int moe_slot_row(const Frame& F, int slot) { const int v = F_SPOS[slot]; return ((const LAS int*)(F.lds + LDS_MOE))[16 + (v >> 20)] * 256 + (v & 0xFFFFF); }
template <bool DRY = false>
__device__ __forceinline__ void phase_norm1(const Frame& F, int l) {
    const int gw = F.bid * 8 + F.wave, NGW = F.G * 8, lane = F.lane;
    const int per = (MT + NGW - 1) / NGW, mstart = gw * per, mend = (mstart + per < MT) ? mstart + per : MT;
    const float* gmix = inptr(F, 6) + l * 1024;
    f32x4 gm[4];
#pragma unroll
    for (int j = 0; j < 4; ++j) gm[j] = *(const f32x4*)(gmix + 4 * lane + 256 * j);
    f32x4 ga[4], shv[4], g5v[4];
    struct Row { f32x4 xf[4]; u32x2 xb[4]; unsigned y0[4], y1[4]; float w0, w1; };
    Row R0, R1, R2, R3;
#define N1_LOAD(R, m) do { const bool _lat = (m) < ML; \
        if (l == 0) { const float* _xin = _lat ? inptr(F, 0) + (size_t)(m) * D : inptr(F, 2) + (size_t)((m) - ML) * D; _Pragma("unroll") for (int j = 0; j < 4; ++j) R.xf[j] = *(const f32x4*)(_xin + 4 * lane + 256 * j); } \
        else { const bf16* _x = F_XB + (size_t)(m) * D; const int _i = (m) - mstart; const fp8* _y0 = F_YBUF + (size_t)__builtin_amdgcn_readlane(rowA, _i) * D; const fp8* _y1 = F_YBUF + (size_t)__builtin_amdgcn_readlane(rowB, _i) * D; \
            R.w0 = __int_as_float(__builtin_amdgcn_readlane(__float_as_int(wA), _i)); R.w1 = __int_as_float(__builtin_amdgcn_readlane(__float_as_int(wB), _i)); \
            _Pragma("unroll") for (int j = 0; j < 4; ++j) { R.xb[j] = *(const u32x2*)(_x + 4 * lane + 256 * j); R.y0[j] = *(const unsigned*)(_y0 + 4 * lane + 256 * j); R.y1[j] = *(const unsigned*)(_y1 + 4 * lane + 256 * j); } } asm volatile("" ::: "memory"); } while (0)
#define N1_DO(R, m) do { \
        f32x4 v[4]; \
        if (l == 0) { _Pragma("unroll") for (int j = 0; j < 4; ++j) v[j] = R.xf[j]; } \
        else { bf16* _xst = F_XB + (size_t)(m) * D; \
            _Pragma("unroll") for (int j = 0; j < 4; ++j) { v[j] = bf4(R.xb[j]) + g5v[j] * (fp84(R.y0[j]) * R.w0 + fp84(R.y1[j]) * R.w1); \
                if (!DRY) { u32x2 _xw; _xw.x = cvt_pk_bf16(v[j][0], v[j][1]); _xw.y = cvt_pk_bf16(v[j][2], v[j][3]); *(u32x2*)(_xst + 4 * lane + 256 * j) = _xw; } } } \
        f32x2 _s2 = {0.f, 0.f};     \
        _Pragma("unroll") for (int j = 0; j < 4; ++j) { _s2 += v[j].xy * v[j].xy; _s2 += v[j].zw * v[j].zw; } \
        int _ri = __builtin_amdgcn_readfirstlane(__float_as_int(__builtin_amdgcn_rsqf(wave_sum(_s2[0] + _s2[1], lane) * (1.0f / D) + EPS))); asm volatile("" : "+s"(_ri)); const float _rstd = __int_as_float(_ri);     \
        fp8* _o = F_HX8 + (size_t)(m) * D; \
        _Pragma("unroll") for (int j = 0; j < 4; ++j) { const f32x4 _h = v[j] * _rstd * ga[j] + shv[j]; *(unsigned*)(_o + 4 * lane + 256 * j) = pk4_fp8(_h[0], _h[1], _h[2], _h[3]); } } while (0)
    int rowA = 0, rowB = 0; float wA = 0.f, wB = 0.f;
    if (l > 0) { moe_tilebase_to_lds(F, l - 1);
        const int mi = mstart + lane; if (lane < per && mi < mend) { rowA = moe_slot_row(F, 2 * mi); rowB = moe_slot_row(F, 2 * mi + 1); wA = F_SLOTW[2 * mi] * 0.0625f; wB = F_SLOTW[2 * mi + 1] * 0.0625f; } }
    for (int m0 = mstart; m0 < mend; ) {
        const int b = m0 < ML ? (m0 >> 11) : 16; const int e0 = (b < 16) ? ((b + 1) << 11) : mend; const int e = e0 < mend ? e0 : mend, el = e - 1;
        { const float* _mp = F_MOD + ((size_t)l * 17 + b) * 6144; const float* _g5 = F_MOD + ((size_t)(l > 0 ? l - 1 : 0) * 17 + b) * 6144 + 5 * 1024;
#pragma unroll
          for (int j = 0; j < 4; ++j) { shv[j] = *(const f32x4*)(_mp + 4 * lane + 256 * j); ga[j] = gm[j] * (*(const f32x4*)(_mp + 1024 + 4 * lane + 256 * j) + 1.0f); g5v[j] = *(const f32x4*)(_g5 + 4 * lane + 256 * j); } }
#define N1_CL(x) ((x) < el ? (x) : el)
        N1_LOAD(R0, m0); N1_LOAD(R1, N1_CL(m0 + 1)); N1_LOAD(R2, N1_CL(m0 + 2));
        for (int m = m0; m < e; m += 4) {
            N1_LOAD(R3, N1_CL(m + 3)); N1_DO(R0, m);
            N1_LOAD(R0, N1_CL(m + 4)); if (m + 1 < e) N1_DO(R1, m + 1);
            N1_LOAD(R1, N1_CL(m + 5)); if (m + 2 < e) N1_DO(R2, m + 2);
            N1_LOAD(R2, N1_CL(m + 6)); if (m + 3 < e) N1_DO(R3, m + 3);
        }
#undef N1_CL
        m0 = e;
    }
#undef N1_LOAD
#undef N1_DO
}

__device__ __forceinline__ void router_fold(const Frame& F, int l) {
    const float* rw = inptr(F, 20); const float* gffn = inptr(F, 7) + l * 1024; const float* modl = F_MOD + (size_t)l * 17 * 6144;
    for (int idx = F.bid * 512 + F.tid; idx < 17 * 32 * 64; idx += F.G * 512) { const int b = idx >> 11, s = (idx >> 6) & 31, ln = idx & 63, g = ln >> 4, e = ln & 15;
        float hi[8], lo[8];
#pragma unroll
        for (int j = 0; j < 8; ++j) { const int k = 32 * s + 8 * g + j; const float v = gffn[k] * (1.0f + modl[b * 6144 + 4 * 1024 + k]) * rw[k * 16 + e];
            const float h = __uint_as_float(cvt_pk_bf16(v, 0.f) << 16); hi[j] = h; lo[j] = v - h; }
        u32x4 wh, wl; wh.x = cvt_pk_bf16(hi[0], hi[1]); wh.y = cvt_pk_bf16(hi[2], hi[3]); wh.z = cvt_pk_bf16(hi[4], hi[5]); wh.w = cvt_pk_bf16(hi[6], hi[7]);
        wl.x = cvt_pk_bf16(lo[0], lo[1]); wl.y = cvt_pk_bf16(lo[2], lo[3]); wl.z = cvt_pk_bf16(lo[4], lo[5]); wl.w = cvt_pk_bf16(lo[6], lo[7]);
        *(u32x4*)(F_RWH + (size_t)idx * 8) = wh; *(u32x4*)(F_RWL + (size_t)idx * 8) = wl; }
    for (int idx = F.bid * 512 + F.tid; idx < 17 * 1024; idx += F.G * 512) { const int b = idx >> 10, k = idx & 1023;
        F_AF[idx] = gffn[k] * (1.0f + modl[b * 6144 + 4 * 1024 + k]); F_BF[idx] = modl[b * 6144 + 3 * 1024 + k]; }
    const int gw = F.bid * 8 + F.wave, NGW = F.G * 8, lane = F.lane;
    for (int o = gw; o < 17 * 16; o += NGW) { const int b = o >> 4, e = o & 15; float acc = 0.f;
#pragma unroll
        for (int j = 0; j < 16; ++j) { const int k = lane + 64 * j; acc += modl[b * 6144 + 3 * 1024 + k] * rw[k * 16 + e]; }
        acc = wave_sum(acc, lane); if (lane == 0) F_CB[o] = acc; }
}
__device__ __forceinline__ void route_select(const float (&lgt)[16], const float (&rb)[16], int& be0, int& be1, float& w0, float& w1) {
    float aff[16], sel[16];
#pragma unroll
    for (int e = 0; e < 16; ++e) { aff[e] = 1.0f / (1.0f + expf(-lgt[e])); sel[e] = aff[e] + rb[e]; }
    float bs = -3.0e38f, ba0 = 0.f, ba1 = 0.f; be0 = 0; be1 = 1;
#pragma unroll
    for (int gg = 0; gg < 4; ++gg) {
        float m1 = sel[4 * gg], a1 = aff[4 * gg]; int i1 = 4 * gg;
#pragma unroll
        for (int k = 1; k < 4; ++k) if (sel[4 * gg + k] > m1) { m1 = sel[4 * gg + k]; a1 = aff[4 * gg + k]; i1 = 4 * gg + k; }
        float m2 = -3.0e38f, a2 = 0.f; int i2 = 0;
#pragma unroll
        for (int k = 0; k < 4; ++k) if ((4 * gg + k) != i1 && sel[4 * gg + k] > m2) { m2 = sel[4 * gg + k]; a2 = aff[4 * gg + k]; i2 = 4 * gg + k; }
        const float gs = m1 + m2;
        if (gs > bs) { bs = gs; be0 = i1; be1 = i2; ba0 = a1; ba1 = a2; }
    }
    const float inv = 1.0f / (ba0 + ba1); w0 = ba0 * inv; w1 = ba1 * inv;
}
__device__ __forceinline__ void phase_norm2_router(const Frame& F, int l) {
    int tid_ = F.tid; asm volatile("" : "+v"(tid_));
    const int tid = tid_, lane = tid & 63, wave = F.wave;
    const int Mrows = (l == DEPTH - 1) ? ML : MT, NT16 = Mrows / 16;
    LAS unsigned char* RWHl = F.lds; LAS unsigned char* RWLl = F.lds + 32768;
    LAS f32x4* abL = (LAS f32x4*)(F.lds + 65536);
    LAS float* lgL = (LAS float*)(F.lds + 73728) + wave * 256;
    LAS float* ssp = (LAS float*)(F.lds + 81920);
    LAS float* lgp = ssp + 128;
    float rb[16];
#pragma unroll
    for (int e = 0; e < 16; ++e) rb[e] = inptr(F, 21)[e];
    int my_e0 = 0, my_e1 = 0, my_m = -1; float my_w0 = 0.f, my_w1 = 0.f;
#define N2_STAGE(b) do { \
        _Pragma("unroll") for (int i = 0; i < 4; ++i) { const int idx = tid + 512 * i; *(LAS u32x4*)(RWHl + idx * 16) = *(const u32x4*)(F_RWH + ((size_t)(b) * 2048 + idx) * 8); *(LAS u32x4*)(RWLl + idx * 16) = *(const u32x4*)(F_RWL + ((size_t)(b) * 2048 + idx) * 8); } \
        abL[tid] = *((const f32x4*)((tid < 256 ? F_AF : F_BF) + (b) * 1024) + (tid & 255)); } while (0)
    const int t1 = F.bid * 8 + wave;
    if (F.bid * 8 < NT16) {
        const int b = (128 * F.bid < ML) ? ((128 * F.bid) >> 11) : 16;
        N2_STAGE(b);
        __syncthreads();
        if (t1 < NT16) {
            int g_ = lane >> 4, r_ = lane & 15; asm volatile("" : "+v"(g_), "+v"(r_) :: "memory");
            const int g = g_, r = r_;
            const int m = 16 * t1 + r;
            const bf16* xrow = F_XB + (size_t)m * D + 8 * g;
            u32x4 xr[32];
#pragma unroll
            for (int s = 0; s < 32; ++s) xr[s] = *(const u32x4*)(xrow + 32 * s);
            float ss = 0.f;
#pragma unroll
            for (int s = 0; s < 32; ++s) { const u32x4 w = xr[s];
                const float a0 = bflo(w.x), a1 = bfhi(w.x), a2 = bflo(w.y), a3 = bfhi(w.y), a4 = bflo(w.z), a5 = bfhi(w.z), a6 = bflo(w.w), a7 = bfhi(w.w);
                ss += ((a0 * a0 + a1 * a1) + (a2 * a2 + a3 * a3)) + ((a4 * a4 + a5 * a5) + (a6 * a6 + a7 * a7)); }
            ss += shx(ss, 16, lane); ss += shx(ss, 32, lane);
            const float rstd = 1.0f / sqrtf(ss * (1.0f / D) + EPS);
            f32x4 acc = (f32x4){0.f, 0.f, 0.f, 0.f};
#pragma unroll
            for (int s = 0; s < 32; ++s) { const bf16x8 bh = *(const LAS bf16x8*)(RWHl + (s * 64 + lane) * 16), bl = *(const LAS bf16x8*)(RWLl + (s * 64 + lane) * 16); const bf16x8 xa = __builtin_bit_cast(bf16x8, xr[s]);
                acc = __builtin_amdgcn_mfma_f32_16x16x32_bf16(xa, bh, acc, 0, 0, 0); acc = __builtin_amdgcn_mfma_f32_16x16x32_bf16(xa, bl, acc, 0, 0, 0); }
            fp8* orow = F_HX8 + (size_t)m * D + 8 * g;
#pragma unroll
            for (int s = 0; s < 32; ++s) { const int k4 = 8 * s + 2 * g; u32x4 w = xr[s]; asm volatile("" : "+v"(w));
                const f32x4 a0 = abL[k4], a1 = abL[k4 + 1], h0 = abL[256 + k4], h1 = abL[256 + k4 + 1];
                const f32x4 x0 = (f32x4){bflo(w.x), bfhi(w.x), bflo(w.y), bfhi(w.y)}, x1 = (f32x4){bflo(w.z), bfhi(w.z), bflo(w.w), bfhi(w.w)};
                const f32x4 y0 = x0 * rstd * a0 + h0, y1 = x1 * rstd * a1 + h1;
                u32x2 o; o.x = pk4_fp8(y0[0], y0[1], y0[2], y0[3]); o.y = pk4_fp8(y1[0], y1[1], y1[2], y1[3]); *(u32x2*)(orow + 32 * s) = o; }
            const float cbv = F_CB[b * 16 + r];
#pragma unroll
            for (int j = 0; j < 4; ++j) { const float rs = __int_as_float(__builtin_amdgcn_ds_bpermute((4 * g + j) << 2, __float_as_int(rstd)));
                lgL[(4 * g + j) * 16 + r] = acc[j] * rs + cbv; }
            asm volatile("s_waitcnt lgkmcnt(0)" ::: "memory");
            float lgt[16];
#pragma unroll
            for (int q4 = 0; q4 < 4; ++q4) { const f32x4 v = *(const LAS f32x4*)(lgL + r * 16 + 4 * q4); lgt[4 * q4] = v[0]; lgt[4 * q4 + 1] = v[1]; lgt[4 * q4 + 2] = v[2]; lgt[4 * q4 + 3] = v[3]; }
            int be0, be1; float w0, w1; route_select(lgt, rb, be0, be1, w0, w1);
            if ((lane >> 4) == 0) { my_e0 = be0; my_e1 = be1; my_w0 = w0; my_w1 = w1; my_m = m; }
        }
    }
    int ord = 1;
    for (int t2 = 8 * F.G + F.bid; t2 < NT16; t2 += F.G, ++ord) {
        const int m0 = 16 * t2, b = (m0 < ML) ? (m0 >> 11) : 16;
        __syncthreads();
        N2_STAGE(b);
        __syncthreads();
        int g_ = lane >> 4, r_ = lane & 15; asm volatile("" : "+v"(g_), "+v"(r_) :: "memory");
        const int g = g_, r = r_;
        const int m = m0 + r;
        const bf16* xrow = F_XB + (size_t)m * D + 8 * g + 128 * wave;
        u32x4 xq[4];
#pragma unroll
        for (int s = 0; s < 4; ++s) xq[s] = *(const u32x4*)(xrow + 32 * s);
        float ss = 0.f; f32x4 acc = (f32x4){0.f, 0.f, 0.f, 0.f};
#pragma unroll
        for (int s = 0; s < 4; ++s) { const u32x4 w = xq[s]; const int sg = 4 * wave + s;
            const float a0 = bflo(w.x), a1 = bfhi(w.x), a2 = bflo(w.y), a3 = bfhi(w.y), a4 = bflo(w.z), a5 = bfhi(w.z), a6 = bflo(w.w), a7 = bfhi(w.w);
            ss += ((a0 * a0 + a1 * a1) + (a2 * a2 + a3 * a3)) + ((a4 * a4 + a5 * a5) + (a6 * a6 + a7 * a7));
            const bf16x8 bh = *(const LAS bf16x8*)(RWHl + (sg * 64 + lane) * 16), bl = *(const LAS bf16x8*)(RWLl + (sg * 64 + lane) * 16); const bf16x8 xa = __builtin_bit_cast(bf16x8, w);
            acc = __builtin_amdgcn_mfma_f32_16x16x32_bf16(xa, bh, acc, 0, 0, 0); acc = __builtin_amdgcn_mfma_f32_16x16x32_bf16(xa, bl, acc, 0, 0, 0); }
        ss += shx(ss, 16, lane); ss += shx(ss, 32, lane);
        if (g == 0) ssp[wave * 16 + r] = ss;
#pragma unroll
        for (int j = 0; j < 4; ++j) lgp[wave * 256 + (4 * g + j) * 16 + r] = acc[j];
        __syncthreads();
        float tot = 0.f;
#pragma unroll
        for (int w = 0; w < 8; ++w) tot += ssp[w * 16 + r];
        const float rstd = 1.0f / sqrtf(tot * (1.0f / D) + EPS);
        fp8* orow = F_HX8 + (size_t)m * D + 8 * g + 128 * wave;
#pragma unroll
        for (int s = 0; s < 4; ++s) { const int k4 = 8 * (4 * wave + s) + 2 * g; const u32x4 w = xq[s];
            const f32x4 a0 = abL[k4], a1 = abL[k4 + 1], h0 = abL[256 + k4], h1 = abL[256 + k4 + 1];
            const f32x4 x0 = (f32x4){bflo(w.x), bfhi(w.x), bflo(w.y), bfhi(w.y)}, x1 = (f32x4){bflo(w.z), bfhi(w.z), bflo(w.w), bfhi(w.w)};
            const f32x4 y0 = x0 * rstd * a0 + h0, y1 = x1 * rstd * a1 + h1;
            u32x2 o; o.x = pk4_fp8(y0[0], y0[1], y0[2], y0[3]); o.y = pk4_fp8(y1[0], y1[1], y1[2], y1[3]); *(u32x2*)(orow + 32 * s) = o; }
        if (wave == 0) {
            float lgt[16];
#pragma unroll
            for (int q4 = 0; q4 < 4; ++q4) { f32x4 v = (f32x4){0.f, 0.f, 0.f, 0.f};
#pragma unroll
                for (int w = 0; w < 8; ++w) v += *(const LAS f32x4*)(lgp + w * 256 + r * 16 + 4 * q4);
                const f32x4 cb4 = *(const f32x4*)(F_CB + b * 16 + 4 * q4);
                lgt[4 * q4] = v[0] * rstd + cb4[0]; lgt[4 * q4 + 1] = v[1] * rstd + cb4[1]; lgt[4 * q4 + 2] = v[2] * rstd + cb4[2]; lgt[4 * q4 + 3] = v[3] * rstd + cb4[3]; }
            int be0, be1; float w0, w1; route_select(lgt, rb, be0, be1, w0, w1);
            if ((lane >> 4) == ord) { my_e0 = be0; my_e1 = be1; my_w0 = w0; my_w1 = w1; my_m = m; }
        }
    }
#undef N2_STAGE
    __syncthreads();
    {
        LAS int* cntw = (LAS int*)(F.lds + 98304);
        LAS int* baseL = cntw + 128;
        const bool valid = my_m >= 0; const unsigned long long lt = (1ull << lane) - 1ull;
        int r0 = 0, r1 = 0, mycnt = 0;
#pragma unroll
        for (int e = 0; e < 16; ++e) {
            const unsigned long long m0 = __ballot(valid && my_e0 == e), m1 = __ballot(valid && my_e1 == e);
            if (my_e0 == e) r0 = __popcll(m0 & lt);
            if (my_e1 == e) r1 = __popcll(m0) + __popcll(m1 & lt);
            if (lane == e) mycnt = __popcll(m0) + __popcll(m1);
        }
        if (lane < 16) cntw[wave * 16 + lane] = mycnt;
        __syncthreads();
        if (tid < 16) { int tot = 0;
#pragma unroll
            for (int w = 0; w < 8; ++w) { const int c = cntw[w * 16 + tid]; cntw[w * 16 + tid] = tot; tot += c; }
            baseL[tid] = (int)atomicAdd(F_CTL + CW_MOE + (l * 16 + tid) * 64, (unsigned)tot); }
        __syncthreads();
        if (valid) {
            F_SLOTW[2 * my_m] = my_w0; F_SLOTW[2 * my_m + 1] = my_w1;
            const int p0 = baseL[my_e0] + cntw[wave * 16 + my_e0] + r0, p1 = baseL[my_e1] + cntw[wave * 16 + my_e1] + r1;
            F_LIST[(size_t)my_e0 * MT + p0] = 2 * my_m; F_LIST[(size_t)my_e1 * MT + p1] = 2 * my_m + 1;
            F_SPOS[2 * my_m] = (my_e0 << 20) | p0; F_SPOS[2 * my_m + 1] = (my_e1 << 20) | p1;
        }
    }
    __syncthreads();
}

__device__ __forceinline__ void moe_setup(const Frame& F, int l, MoeOrder& S, int NT) {
    LAS int* tab = (LAS int*)(F.lds + LDS_MOE);
    LAS int* rows = (LAS int*)(F.lds + LDS_ROWS);
    if (F.tid < 16) tab[F.tid] = (int)__hip_atomic_load(F_CTL + CW_MOE + (l * 16 + F.tid) * 64, __ATOMIC_RELAXED, __HIP_MEMORY_SCOPE_AGENT);
    __syncthreads();
    if (F.tid == 0) { int acc = 0;
#pragma unroll
        for (int e = 0; e < 16; ++e) { tab[16 + e] = acc; acc += (tab[e] + 255) >> 8; }
        tab[32] = acc; }
    __syncthreads();
    S.mbase = tab + 16; S.rows = rows; S.NT = NT; S.G = F.G; S.c = F.bid; S.TM = __builtin_amdgcn_readfirstlane(tab[32]); S.rowbytes = 1024u;
    if (NT == 8 && F.tid < 256) {
        int val[MAXU]; bool keep[MAXU];
#pragma unroll
        for (int i = 0; i < MAXU; ++i) { pg8::Unit u; const bool ok = S.next(i, u);
            const int e = ok ? u.pn / NT : 0, jt = ok ? u.pm - tab[16 + e] : 0, r = jt * 256 + F.tid; const bool in = ok && (r < tab[e]);
            val[i] = F_LIST[(size_t)e * MT + (in ? r : 0)]; keep[i] = in; }
#pragma unroll
        for (int i = 0; i < MAXU; ++i) rows[i * 256 + F.tid] = keep[i] ? val[i] : -1;
    }
    __syncthreads();
}

__device__ __forceinline__ void na_unit(const Frame& F, int l, int kind, int b, int h, int idx) {
    LAS unsigned char* Kl = F.lds;
    LAS float* rpbL = (LAS float*)(F.lds + 110592);
    LAS float* mrg = (LAS float*)(F.lds + 112640);
    const int tid = F.tid, lane = F.lane, w = F.wave, g = lane >> 4, c = lane & 15, qb = w & 3, part = w >> 2;
    const int r = idx, r0 = (r - 4 < 0) ? 0 : ((r - 4 > 24) ? 24 : r - 4);
    const bf16* px = F_PX;
#define NA_STAGE(COL) do { \
        if (kind == 0) { \
            _Pragma("unroll") for (int k = 0; k < 8; ++k) { const int ch = tid + 512 * k, key = ch >> 3, p = ch & 7; \
                *(LAS u32x4*)(Kl + key * 144 + p * 16) = *(const u32x4*)(((COL) == C_NK ? F_KNL : F_VNL) + ((size_t)(b * 6 + h) * 2048 + r0 * 64) * 64 + ch * 8); } \
            _Pragma("unroll") for (int k = 0; k < 4; ++k) { const int ch = tid + 512 * k, key = ch >> 3, p = ch & 7; \
                *(LAS u32x4*)(Kl + (512 + key) * 144 + p * 16) = *(const u32x4*)(((COL) == C_NK ? F_KNC : F_VNC) + (size_t)(b * 6 + h) * 256 * 64 + ch * 8); } \
        } else { \
            _Pragma("unroll") for (int k = 0; k < 6; ++k) { const int ch = tid + 512 * k, row = ch >> 3, p = ch & 7; \
                *(LAS u32x4*)(Kl + row * 144 + p * 16) = *(const u32x4*)(((COL) == C_NK ? F_KNC : F_VNC) + ((size_t)(b * 6 + h) * 256 + (row & 255)) * 64 + p * 8); } \
        } } while (0)
    NA_STAGE(C_NK);
    if (kind == 0) { const float* rp = inptr(F, 14) + ((size_t)l * 6 + h) * 465; for (int i = tid; i < 465; i += 512) rpbL[i] = rp[i]; }
    const int mq = (kind == 0) ? (b * 2048 + r * 64 + 16 * qb + c) : (ML + b * 256 + idx * 64 + 16 * qb + c);
    const bf16x8 q0 = *(const bf16x8*)(px + (size_t)mq * NPX + C_NQ + h * 64 + 8 * g), q1 = *(const bf16x8*)(px + (size_t)mq * NPX + C_NQ + h * 64 + 32 + 8 * g);
    __syncthreads();
    const int cs = (kind == 0) ? (qb == 0 ? 0 : (qb == 1 ? 8 : (qb == 2 ? 24 : 32))) : 0;
    const int kbase = (kind == 0) ? (part == 0 ? cs : 512) : part * 128;
    const int st2 = ((kind == 0 && part == 0) ? 64 : 32) * 144;
    const int abase = (kbase + c) * 144 + 16 * g;
    f32x4 s[16];
#pragma unroll
    for (int t = 0; t < 16; ++t) {
        const LAS unsigned char* kp = Kl + abase + (t >> 1) * st2 + (t & 1) * 2304;
        const bf16x8 a0 = *(const LAS bf16x8*)(kp), a1 = *(const LAS bf16x8*)(kp + 64);
        f32x4 z = (f32x4){0.f, 0.f, 0.f, 0.f};
        z = __builtin_amdgcn_mfma_f32_16x16x32_bf16(a0, q0, z, 0, 0, 0);
        z = __builtin_amdgcn_mfma_f32_16x16x32_bf16(a1, q1, z, 0, 0, 0);
        s[t] = z;
    }
    const float NEG = -__builtin_inff();
    if (kind == 0 && part == 0) {
        const int cq = 16 * qb + c, c0 = (cq - 8 < 0) ? 0 : ((cq - 8 > 48) ? 48 : cq - 8);
#pragma unroll
        for (int t = 0; t < 16; ++t) { const int i = t >> 1, drow = r0 + i - r + 7;
#pragma unroll
            for (int j = 0; j < 4; ++j) { const int col = cs + 16 * (t & 1) + 4 * g + j; const bool valid = (col >= c0) && (col < c0 + 16);
                int dcol = col - cq + 15; dcol = dcol < 0 ? 0 : (dcol > 30 ? 30 : dcol);
                const float bias = rpbL[drow * 31 + dcol];
                s[t][j] = valid ? (s[t][j] * 0.125f + bias) : NEG; } }
    } else if (kind == 0) {
#pragma unroll
        for (int t = 0; t < 16; ++t) s[t] = s[t] * 0.125f;
    } else {
#pragma unroll
        for (int t = 0; t < 16; ++t) {
#pragma unroll
            for (int j = 0; j < 4; ++j) s[t][j] = (t < 8) ? s[t][j] * 0.125f : NEG; }
    }
    float mx = NEG;
#pragma unroll
    for (int t = 0; t < 16; ++t)
#pragma unroll
        for (int j = 0; j < 4; ++j) mx = fmaxf(mx, s[t][j]);
    mx = fmaxf(mx, shx(mx, 16, lane)); mx = fmaxf(mx, shx(mx, 32, lane));
    float lsum = 0.f;
#pragma unroll
    for (int t = 0; t < 16; ++t)
#pragma unroll
        for (int j = 0; j < 4; ++j) { const float p = __expf(s[t][j] - mx); s[t][j] = p; lsum += p; }
    lsum += shx(lsum, 16, lane); lsum += shx(lsum, 32, lane);
    __syncthreads();
    NA_STAGE(C_NV);
    __syncthreads();
    f32x4 o[4];
#pragma unroll
    for (int nt = 0; nt < 4; ++nt) o[nt] = (f32x4){0.f, 0.f, 0.f, 0.f};
    const int vbase = (kbase + 4 * g + (c >> 2)) * 144 + 8 * (c & 3);
#pragma unroll
    for (int ks = 0; ks < 8; ++ks) {
        bf16x8 pb; { const unsigned w0 = cvt_pk_bf16(s[2 * ks][0], s[2 * ks][1]), w1 = cvt_pk_bf16(s[2 * ks][2], s[2 * ks][3]), w2 = cvt_pk_bf16(s[2 * ks + 1][0], s[2 * ks + 1][1]), w3 = cvt_pk_bf16(s[2 * ks + 1][2], s[2 * ks + 1][3]);
            u32x4 pw = (u32x4){w0, w1, w2, w3}; pb = __builtin_bit_cast(bf16x8, pw); }
        LAS unsigned char* vp = Kl + vbase + ks * st2;
#pragma unroll
        for (int nt = 0; nt < 4; ++nt) {
            const s16x4 t0 = __builtin_amdgcn_ds_read_tr16_b64_v4i16((LAS s16x4*)(vp + 32 * nt));
            const s16x4 t1 = __builtin_amdgcn_ds_read_tr16_b64_v4i16((LAS s16x4*)(vp + 2304 + 32 * nt));
            const bf16x8 va = (bf16x8){t0[0], t0[1], t0[2], t0[3], t1[0], t1[1], t1[2], t1[3]};
            o[nt] = __builtin_amdgcn_mfma_f32_16x16x32_bf16(va, pb, o[nt], 0, 0, 0);
        }
    }
    if (part == 1) { LAS float* mp = mrg + (qb * 64 + lane) * 18; mp[0] = mx; mp[1] = lsum;
#pragma unroll
        for (int nt = 0; nt < 4; ++nt)
#pragma unroll
            for (int j = 0; j < 4; ++j) mp[2 + 4 * nt + j] = o[nt][j]; }
    __syncthreads();
    if (part == 0) { const LAS float* mp = mrg + (qb * 64 + lane) * 18; const float m2 = mp[0], l2 = mp[1];
        const float M = fmaxf(mx, m2), f1 = __expf(mx - M), f2 = __expf(m2 - M), inv = 1.0f / (lsum * f1 + l2 * f2);
        fp8* op = F_MIX + (size_t)mq * D + 384 + h * 64 + 4 * g;
#pragma unroll
        for (int nt = 0; nt < 4; ++nt) { float r4[4];
#pragma unroll
            for (int j = 0; j < 4; ++j) r4[j] = (o[nt][j] * f1 + mp[2 + 4 * nt + j] * f2) * inv;
            *(unsigned*)(op + 16 * nt) = pk4_fp8(r4[0], r4[1], r4[2], r4[3]); } }
    __syncthreads();
#undef NA_STAGE
}

__device__ __forceinline__ void na_latent_phase(const Frame& F, int l) {
    LAS unsigned char* Kl = F.lds;
    LAS float* rpbL = (LAS float*)(F.lds + 110592);
    LAS float* mrg = (LAS float*)(F.lds + 112640);
    int tid_ = F.tid; asm volatile("" : "+v"(tid_));
    const int tid = tid_, lane = tid & 63, w = F.wave, g = lane >> 4, c = lane & 15, qb = w & 3, part = w >> 2;
    const bf16* px = F_PX;
    const int r = F.bid >> 3, r0 = (r - 4 < 0) ? 0 : ((r - 4 > 24) ? 24 : r - 4), bh0 = F.bid & 7;
    u32x4 kv[12]; bf16x8 qn0, qn1; float rpn = 0.f;
#define NA_LOAD(COL, ii) do { const int _bh = bh0 + 8 * (ii), _b = _bh / 6, _h = _bh % 6; \
        _Pragma("unroll") for (int k = 0; k < 8; ++k) { const int ch = tid + 512 * k; \
            kv[k] = *(const u32x4*)(((COL) == C_NK ? F_KNL : F_VNL) + ((size_t)(_b * 6 + _h) * 2048 + r0 * 64) * 64 + ch * 8); }        \
        _Pragma("unroll") for (int k = 0; k < 4; ++k) { const int ch = tid + 512 * k; \
            kv[8 + k] = *(const u32x4*)(((COL) == C_NK ? F_KNC : F_VNC) + (size_t)(_b * 6 + _h) * 256 * 64 + ch * 8); } } while (0)
#define NA_PUT() do { \
        _Pragma("unroll") for (int k = 0; k < 8; ++k) { const int ch = tid + 512 * k, key = ch >> 3, p = ch & 7; *(LAS u32x4*)(Kl + key * 144 + p * 16) = kv[k]; } \
        _Pragma("unroll") for (int k = 0; k < 4; ++k) { const int ch = tid + 512 * k, key = ch >> 3, p = ch & 7; *(LAS u32x4*)(Kl + (512 + key) * 144 + p * 16) = kv[8 + k]; } } while (0)
#define NA_LOADQ(ii) do { const int _bh = bh0 + 8 * (ii), _b = _bh / 6, _h = _bh % 6; const int _mq = _b * 2048 + r * 64 + 16 * qb + c; \
        qn0 = *(const bf16x8*)(px + (size_t)_mq * NPX + C_NQ + _h * 64 + 8 * g); qn1 = *(const bf16x8*)(px + (size_t)_mq * NPX + C_NQ + _h * 64 + 32 + 8 * g); \
        if (tid < 465) rpn = inptr(F, 14)[((size_t)l * 6 + _h) * 465 + tid]; } while (0)
    NA_LOAD(C_NK, 0); NA_LOADQ(0);
    const int cs = (qb == 0 ? 0 : (qb == 1 ? 8 : (qb == 2 ? 24 : 32)));
    const int kbase = (part == 0 ? cs : 512), st2 = (part == 0 ? 64 : 32) * 144;
    const int abase = (kbase + c) * 144 + 16 * g, vbase = (kbase + 4 * g + (c >> 2)) * 144 + 8 * (c & 3);
    const float NEG = -__builtin_inff();
    int bcol[8];
    { const int cq = 16 * qb + c, c0 = (cq - 8 < 0) ? 0 : ((cq - 8 > 48) ? 48 : cq - 8);
#pragma unroll
      for (int k = 0; k < 8; ++k) { const int col = cs + 16 * (k >> 2) + 4 * g + (k & 3); const bool valid = (col >= c0) && (col < c0 + 16);
          int dcol = col - cq + 15; dcol = dcol < 0 ? 0 : (dcol > 30 ? 30 : dcol); bcol[k] = valid ? dcol : 31; } }
    const int rpw = (tid < 465) ? (tid / 31) * 32 + tid % 31 : 0;
    for (int i = 0; i < 12; ++i) {
        const int bh = bh0 + 8 * i, b = bh / 6, h = bh % 6;
        NA_PUT();
        if (tid < 465) rpbL[rpw] = rpn * 1.4426950408889634f; else if (tid < 480) rpbL[(tid - 465) * 32 + 31] = NEG;
        const bf16x8 q0 = qn0, q1 = qn1;
        NA_LOAD(C_NV, i);
        __syncthreads();
        f32x4 s[16];
#pragma unroll
        for (int t = 0; t < 16; ++t) {
            const LAS unsigned char* kp = Kl + abase + (t >> 1) * st2 + (t & 1) * 2304;
            const bf16x8 a0 = *(const LAS bf16x8*)(kp), a1 = *(const LAS bf16x8*)(kp + 64);
            f32x4 z = (f32x4){0.f, 0.f, 0.f, 0.f};
            z = __builtin_amdgcn_mfma_f32_16x16x32_bf16(a0, q0, z, 0, 0, 0);
            z = __builtin_amdgcn_mfma_f32_16x16x32_bf16(a1, q1, z, 0, 0, 0);
            s[t] = z;
        }
        constexpr float L2E = 1.4426950408889634f;
        if (part == 0) {
#pragma unroll
            for (int t = 0; t < 16; ++t) { const LAS float* brow = rpbL + (r0 + (t >> 1) - r + 7) * 32; const int k0 = 4 * (t & 1);
                f32x4 bias; bias[0] = brow[bcol[k0]]; bias[1] = brow[bcol[k0 + 1]]; bias[2] = brow[bcol[k0 + 2]]; bias[3] = brow[bcol[k0 + 3]];
                s[t] = s[t] * (0.125f * L2E) + bias; }
        } else {
#pragma unroll
            for (int t = 0; t < 16; ++t) s[t] = s[t] * (0.125f * L2E);
        }
        float mx;
        { f32x4 m4 = s[0];
#pragma unroll
          for (int t = 1; t < 16; ++t) { m4[0] = fmaxf(m4[0], s[t][0]); m4[1] = fmaxf(m4[1], s[t][1]); m4[2] = fmaxf(m4[2], s[t][2]); m4[3] = fmaxf(m4[3], s[t][3]); }
          mx = fmaxf(fmaxf(m4[0], m4[1]), fmaxf(m4[2], m4[3])); }
        mx = fmaxf(mx, shx(mx, 16, lane)); mx = fmaxf(mx, shx(mx, 32, lane));
        float lsum;
        { f32x4 l4 = (f32x4){0.f, 0.f, 0.f, 0.f};
#pragma unroll
          for (int t = 0; t < 16; ++t) { const f32x4 d = s[t] - mx; f32x4 p; p[0] = __builtin_amdgcn_exp2f(d[0]); p[1] = __builtin_amdgcn_exp2f(d[1]); p[2] = __builtin_amdgcn_exp2f(d[2]); p[3] = __builtin_amdgcn_exp2f(d[3]); s[t] = p; l4 += p; }
          lsum = (l4[0] + l4[1]) + (l4[2] + l4[3]); }
        lsum += shx(lsum, 16, lane); lsum += shx(lsum, 32, lane);
        __syncthreads();
        NA_PUT();
        if (i + 1 < 12) { NA_LOAD(C_NK, i + 1); NA_LOADQ(i + 1); }
        __syncthreads();
        f32x4 o[4];
#pragma unroll
        for (int nt = 0; nt < 4; ++nt) o[nt] = (f32x4){0.f, 0.f, 0.f, 0.f};
#pragma unroll
        for (int ks = 0; ks < 8; ++ks) {
            bf16x8 pb; { u32x4 pw = (u32x4){cvt_pk_bf16(s[2 * ks][0], s[2 * ks][1]), cvt_pk_bf16(s[2 * ks][2], s[2 * ks][3]), cvt_pk_bf16(s[2 * ks + 1][0], s[2 * ks + 1][1]), cvt_pk_bf16(s[2 * ks + 1][2], s[2 * ks + 1][3])}; pb = __builtin_bit_cast(bf16x8, pw); }
            LAS unsigned char* vp = Kl + vbase + ks * st2;
#pragma unroll
            for (int nt = 0; nt < 4; ++nt) {
                const s16x4 t0 = __builtin_amdgcn_ds_read_tr16_b64_v4i16((LAS s16x4*)(vp + 32 * nt));
                const s16x4 t1 = __builtin_amdgcn_ds_read_tr16_b64_v4i16((LAS s16x4*)(vp + 2304 + 32 * nt));
                const bf16x8 va = (bf16x8){t0[0], t0[1], t0[2], t0[3], t1[0], t1[1], t1[2], t1[3]};
                o[nt] = __builtin_amdgcn_mfma_f32_16x16x32_bf16(va, pb, o[nt], 0, 0, 0);
            }
        }
        if (part == 1) { LAS float* mp = mrg + (qb * 64 + lane) * 18; mp[0] = mx; mp[1] = lsum;
#pragma unroll
            for (int nt = 0; nt < 4; ++nt)
#pragma unroll
                for (int j = 0; j < 4; ++j) mp[2 + 4 * nt + j] = o[nt][j]; }
        __syncthreads();
        if (part == 0) { const LAS float* mp = mrg + (qb * 64 + lane) * 18; const float m2 = mp[0], l2 = mp[1];
            const float M = fmaxf(mx, m2), f1 = __builtin_amdgcn_exp2f(mx - M), f2 = __builtin_amdgcn_exp2f(m2 - M), inv = 1.0f / (lsum * f1 + l2 * f2);
            const int mq = b * 2048 + r * 64 + 16 * qb + c;
            fp8* op = F_MIX + (size_t)mq * D + 384 + h * 64 + 4 * g;
#pragma unroll
            for (int nt = 0; nt < 4; ++nt) { float r4[4];
#pragma unroll
                for (int j = 0; j < 4; ++j) r4[j] = (o[nt][j] * f1 + mp[2 + 4 * nt + j] * f2) * inv;
                *(unsigned*)(op + 16 * nt) = pk4_fp8(r4[0], r4[1], r4[2], r4[3]); } }
    }
    __syncthreads();
#undef NA_LOAD
#undef NA_PUT
#undef NA_LOADQ
}

__device__ __forceinline__ void conv_unit(const Frame& F, int l, int mbase, int len, int t0) {
    LAS float* hcv = (LAS float*)F.lds;
    LAS float* ob = (LAS float*)(F.lds + 62 * 256 * 4);
    const int tid = F.tid, lane = F.lane;
    const bf16* px = F_PX;
    for (int ch = tid; ch < 62 * 32; ch += 512) { const int rr = ch >> 5, c8 = (ch & 31) * 8, t = t0 - 15 + rr;
        f32x4 lo = (f32x4){0.f, 0.f, 0.f, 0.f}, hi = lo;
        if (t >= 0 && t < len) { const bf16* p = px + (size_t)(mbase + t) * NPX; const u32x4 a = *(const u32x4*)(p + C_CV + c8), gt = *(const u32x4*)(p + C_CG + c8);
            lo[0] = bflo(a.x) * sigmoid_f(bflo(gt.x)); lo[1] = bfhi(a.x) * sigmoid_f(bfhi(gt.x)); lo[2] = bflo(a.y) * sigmoid_f(bflo(gt.y)); lo[3] = bfhi(a.y) * sigmoid_f(bfhi(gt.y));
            hi[0] = bflo(a.z) * sigmoid_f(bflo(gt.z)); hi[1] = bfhi(a.z) * sigmoid_f(bfhi(gt.z)); hi[2] = bflo(a.w) * sigmoid_f(bflo(gt.w)); hi[3] = bfhi(a.w) * sigmoid_f(bfhi(gt.w)); }
        *(LAS f32x4*)(hcv + rr * 256 + c8) = lo; *(LAS f32x4*)(hcv + rr * 256 + c8 + 4) = hi; }
    const int c = tid & 255, th = tid >> 8;
    float wv[31];
#pragma unroll
    for (int j = 0; j < 31; ++j) wv[j] = inptr(F, 15)[((size_t)l * 31 + j) * 256 + c];
    const float bias = inptr(F, 16)[l * 256 + c];
    __syncthreads();
    float acc[16];
#pragma unroll
    for (int i = 0; i < 16; ++i) acc[i] = bias;
#pragma unroll
    for (int rr = 0; rr < 46; ++rr) { const float x = hcv[(th * 16 + rr) * 256 + c];
#pragma unroll
        for (int i = 0; i < 16; ++i) { const int j = rr - i; if (j >= 0 && j < 31) acc[i] += x * wv[j]; } }
#pragma unroll
    for (int i = 0; i < 16; ++i) ob[(th * 16 + i) * 256 + c] = acc[i];
    __syncthreads();
    const f32x4 lg = *(const f32x4*)(inptr(F, 17) + l * 256 + 4 * lane), lb = *(const f32x4*)(inptr(F, 18) + l * 256 + 4 * lane);
#pragma unroll
    for (int k = 0; k < 4; ++k) { const int tt = F.wave * 4 + k; const f32x4 x = *(const LAS f32x4*)(ob + tt * 256 + 4 * lane);
        const float mean = wave_sum((x[0] + x[1]) + (x[2] + x[3]), lane) * (1.0f / 256.0f); const f32x4 d = x - mean;
        const float var = wave_sum((d[0] * d[0] + d[1] * d[1]) + (d[2] * d[2] + d[3] * d[3]), lane) * (1.0f / 256.0f); const float rstd = 1.0f / sqrtf(var + EPS);
        const f32x4 y = d * rstd * lg + lb;
        *(unsigned*)(F_MIX + (size_t)(mbase + t0 + tt) * D + 768 + 4 * lane) = pk4_fp8(silu_f(y[0]), silu_f(y[1]), silu_f(y[2]), silu_f(y[3])); }
    __syncthreads();
}

constexpr int GB_TOT = 0;
constexpr int GB_X = 6144;
constexpr int GB_V = 8192;
constexpr int GB_T = GB_V + 64 * 208;
constexpr int GB_SF = GB_T + 4 * 64 * 144, GB_SB = GB_SF + 64 * 208;
constexpr int VST = 208, TST = 144;
static_assert(GB_SB + 64 * VST <= SCR_BYTES, "GLA LDS map");
__device__ __forceinline__ void gla_chunk_info(int b, int cc, int& m0, bool& lat, int& rowpos, int& idxf, int& idxb) {
    lat = cc >= 4;
    if (lat) { const int cl = cc - 4; m0 = b * 2048 + cl * 64; rowpos = cl; idxf = 4 + cl; idxb = 4 + (31 - cl); }
    else { m0 = ML + b * 256 + cc * 64; rowpos = 0; idxf = cc; idxb = 3 - cc; }
}
__device__ __forceinline__ bf16x8 tr_pair(const LAS unsigned char* p0, const LAS unsigned char* p1) {
    const s16x4 t0 = __builtin_amdgcn_ds_read_tr16_b64_v4i16((LAS s16x4*)p0), t1 = __builtin_amdgcn_ds_read_tr16_b64_v4i16((LAS s16x4*)p1);
    return (bf16x8){t0[0], t0[1], t0[2], t0[3], t1[0], t1[1], t1[2], t1[3]};
}
template <bool G3>
__device__ __forceinline__ void gla_stage(const Frame& F, int l, int b, int h, int m0, bool lat, int rowpos, int idxf, int idxb) {
    int tid_ = F.tid; asm volatile("" : "+v"(tid_));
    const int tid = tid_; const bf16* px = F_PX;
    LAS float* TOT = (LAS float*)(F.lds + GB_TOT);
    const size_t chainf = ((size_t)(0 * 16 + b) * 4 + h), chainb = ((size_t)(1 * 16 + b) * 4 + h);
    if (tid >= 384) {
        const int at = tid - 384;
#pragma unroll
        for (int i = 0; i < 6; ++i) { const int idx = at + 128 * i, t = idx / 12, ch = idx % 12;
            *(LAS u32x4*)(F.lds + GB_V + t * VST + ch * 16) = *(const u32x4*)(px + (size_t)(m0 + t) * NPX + C_GV + h * 96 + ch * 8); }
        if constexpr (G3) {
            for (int i = at; i < 2 * 16 * 13; i += 128) { const int dir = i / 208, r = i % 208, d = 48 + r / 13, ch = r % 13; *(LAS u32x4*)(F.lds + (dir ? GB_SB : GB_SF) + d * VST + ch * 16) = (u32x4){0u, 0u, 0u, 0u}; }
            for (int i = at; i < 512; i += 128) { const int row = i >> 1, hf = i & 1; *(LAS u32x4*)(F.lds + GB_T + row * TST + 96 + hf * 16) = (u32x4){0u, 0u, 0u, 0u}; }
        }
    }
    u32x4 sx[3];
    if constexpr (G3) {
        const bf16* gf = F_GST + (chainf * NCH + idxf) * 4608; const bf16* gb = F_GST + (chainb * NCH + idxb) * 4608;
#pragma unroll
        for (int i = 0; i < 3; ++i) { const int idx = tid + 512 * i; if (idx < 1152) { const int dirs = idx / 576, rr = idx % 576; sx[i] = *(const u32x4*)((dirs ? gb : gf) + rr * 8); } }
    }
    float pr_[4][4]; float kk[4][4], qq[4][4];
    const int dir = (tid >= 192) ? 1 : 0, r_ = tid - 192 * dir, dg = r_ >> 4, tg = r_ & 15;
    float* pvg = F_PV + ((((size_t)(b * 4 + h) * NCH + idxf) * 2 + dir) * 64 + 4 * tg) * 48 + 4 * dg;
    f32x4 pvl[4];
    if (tid < 384) {
        u32x4 araw[4][2]; f32x4 wv[16]; f32x4 bav;
        if constexpr (!G3) {
#pragma unroll
        for (int t = 0; t < 4; ++t) { const bf16* ap = px + (size_t)(m0 + 4 * tg + t) * NPX + C_GA + 16 * dir; araw[t][0] = *(const u32x4*)ap; araw[t][1] = *(const u32x4*)(ap + 8); }
        const float* wa = inptr(F, dir ? 11 : 9) + (size_t)l * 16 * 192 + h * 48 + 4 * dg;
#pragma unroll
        for (int j = 0; j < 16; ++j) wv[j] = *(const f32x4*)(wa + j * 192);
        bav = *(const f32x4*)(inptr(F, dir ? 12 : 10) + l * 192 + h * 48 + 4 * dg);
        } else {
#pragma unroll
        for (int t = 0; t < 4; ++t) pvl[t] = *(const f32x4*)(pvg + t * 48);
        }
        u32x2 kraw[4], qraw[4];
#pragma unroll
        for (int t = 0; t < 4; ++t) { const bf16* rp = px + (size_t)(m0 + 4 * tg + t) * NPX + h * 48 + 4 * dg; kraw[t] = *(const u32x2*)(rp + C_GK); if constexpr (G3) qraw[t] = *(const u32x2*)(rp + C_GQ); }
        f32x4 rope[4];
        if (lat) {
#pragma unroll
            for (int t = 0; t < 4; ++t) { const int pos = (dg < 6) ? rowpos : (4 * tg + t), j = (dg < 6) ? 2 * dg : 2 * dg - 12; rope[t] = *(const f32x4*)(F_ROPE + (pos * 12 + j) * 2); }
        }
        if constexpr (!G3) {
#pragma unroll
        for (int t = 0; t < 4; ++t) {
            float a[16];
#pragma unroll
            for (int i = 0; i < 4; ++i) { const unsigned w0 = araw[t][i >> 1][(i & 1) * 2], w1 = araw[t][i >> 1][(i & 1) * 2 + 1]; a[4 * i] = bflo(w0); a[4 * i + 1] = bfhi(w0); a[4 * i + 2] = bflo(w1); a[4 * i + 3] = bfhi(w1); }
            f32x4 x = bav;
#pragma unroll
            for (int j = 0; j < 16; ++j) x += wv[j] * a[j];
            { constexpr float L2E = 1.4426950408889634f;
              f32x4 tt; tt[0] = fabsf(x[0]); tt[1] = fabsf(x[1]); tt[2] = fabsf(x[2]); tt[3] = fabsf(x[3]); tt = tt * (-L2E);
              f32x4 ee; ee[0] = __builtin_amdgcn_exp2f(tt[0]); ee[1] = __builtin_amdgcn_exp2f(tt[1]); ee[2] = __builtin_amdgcn_exp2f(tt[2]); ee[3] = __builtin_amdgcn_exp2f(tt[3]);
              const f32x4 uu = ee + 1.0f;
              f32x4 lg; lg[0] = __builtin_amdgcn_logf(uu[0]); lg[1] = __builtin_amdgcn_logf(uu[1]); lg[2] = __builtin_amdgcn_logf(uu[2]); lg[3] = __builtin_amdgcn_logf(uu[3]);
              f32x4 mn; mn[0] = fminf(x[0], 0.f); mn[1] = fminf(x[1], 0.f); mn[2] = fminf(x[2], 0.f); mn[3] = fminf(x[3], 0.f);
              const f32x4 pr4 = mn * (0.0625f * L2E) - lg * 0.0625f;
              pr_[t][0] = pr4[0]; pr_[t][1] = pr4[1]; pr_[t][2] = pr4[2]; pr_[t][3] = pr4[3]; }
        }
        if (dir == 0) {
#pragma unroll
            for (int t = 1; t < 4; ++t)
#pragma unroll
                for (int d = 0; d < 4; ++d) pr_[t][d] += pr_[t - 1][d];
            *(LAS f32x4*)(TOT + (0 * 16 + tg) * 48 + 4 * dg) = (f32x4){pr_[3][0], pr_[3][1], pr_[3][2], pr_[3][3]};
        } else {
#pragma unroll
            for (int t = 2; t >= 0; --t)
#pragma unroll
                for (int d = 0; d < 4; ++d) pr_[t][d] += pr_[t + 1][d];
            *(LAS f32x4*)(TOT + (1 * 16 + tg) * 48 + 4 * dg) = (f32x4){pr_[0][0], pr_[0][1], pr_[0][2], pr_[0][3]};
        }
        }
#pragma unroll
        for (int t = 0; t < 4; ++t) {
            kk[t][0] = bflo(kraw[t].x); kk[t][1] = bfhi(kraw[t].x); kk[t][2] = bflo(kraw[t].y); kk[t][3] = bfhi(kraw[t].y);
            if constexpr (G3) { qq[t][0] = bflo(qraw[t].x) * 0.14433756729740643f; qq[t][1] = bfhi(qraw[t].x) * 0.14433756729740643f; qq[t][2] = bflo(qraw[t].y) * 0.14433756729740643f; qq[t][3] = bfhi(qraw[t].y) * 0.14433756729740643f; }
            if (lat) {
#pragma unroll
                for (int pp = 0; pp < 2; ++pp) { const float cs = rope[t][2 * pp], sn = rope[t][2 * pp + 1];
                    const float k1 = kk[t][2 * pp], k2 = kk[t][2 * pp + 1]; kk[t][2 * pp] = k1 * cs - k2 * sn; kk[t][2 * pp + 1] = k1 * sn + k2 * cs;
                    if constexpr (G3) { const float q1 = qq[t][2 * pp], q2 = qq[t][2 * pp + 1]; qq[t][2 * pp] = q1 * cs - q2 * sn; qq[t][2 * pp + 1] = q1 * sn + q2 * cs; } }
            }
        }
    }
    if constexpr (G3) {
#pragma unroll
        for (int i = 0; i < 3; ++i) { const int idx = tid + 512 * i; if (idx < 1152) { const int dirs = idx / 576, rr = idx % 576, d = rr / 12, e8 = (rr % 12) * 8;
            *(LAS u32x4*)(F.lds + (dirs ? GB_SB : GB_SF) + d * VST + e8 * 2) = sx[i]; } }
    }
    __syncthreads();
    if (tid < 384) {
        f32x4 off = (f32x4){0.f, 0.f, 0.f, 0.f}, E = off;
        if constexpr (!G3) {
        f32x4 tvs[16];
#pragma unroll
        for (int g2 = 0; g2 < 16; ++g2) tvs[g2] = *(const LAS f32x4*)(TOT + (dir * 16 + g2) * 48 + 4 * dg);
#pragma unroll
        for (int g2 = 0; g2 < 16; ++g2) { const float mk = (dir == 0 ? (g2 < tg) : (g2 > tg)) ? 1.0f : 0.0f; E += tvs[g2]; off += tvs[g2] * mk; }
        }
        LAS unsigned char* base = F.lds + GB_T + (4 * tg) * TST + 8 * dg;
#pragma unroll
        for (int t = 0; t < 4; ++t) {
            float pv[4];
            if constexpr (G3) {
#pragma unroll
                for (int d = 0; d < 4; ++d) pv[d] = pvl[t][d];
            } else {
#pragma unroll
                for (int d = 0; d < 4; ++d) pv[d] = pr_[t][d] + off[d];
                *(f32x4*)(pvg + t * 48) = (f32x4){pv[0], pv[1], pv[2], pv[3]};
            }
            if constexpr (G3) {
                u32x2 wq, wk; wq.x = cvt_pk_bf16(qq[t][0] * __builtin_amdgcn_exp2f(pv[0]), qq[t][1] * __builtin_amdgcn_exp2f(pv[1])); wq.y = cvt_pk_bf16(qq[t][2] * __builtin_amdgcn_exp2f(pv[2]), qq[t][3] * __builtin_amdgcn_exp2f(pv[3]));
                wk.x = cvt_pk_bf16(kk[t][0] * __builtin_amdgcn_exp2f(-pv[0]), kk[t][1] * __builtin_amdgcn_exp2f(-pv[1])); wk.y = cvt_pk_bf16(kk[t][2] * __builtin_amdgcn_exp2f(-pv[2]), kk[t][3] * __builtin_amdgcn_exp2f(-pv[3]));
                *(LAS u32x2*)(base + (dir * 64 + t) * TST) = wq; *(LAS u32x2*)(base + ((2 + dir) * 64 + t) * TST) = wk;
            } else {
                u32x2 wk; wk.x = cvt_pk_bf16(kk[t][0] * __builtin_amdgcn_exp2f(E[0] - pv[0]), kk[t][1] * __builtin_amdgcn_exp2f(E[1] - pv[1])); wk.y = cvt_pk_bf16(kk[t][2] * __builtin_amdgcn_exp2f(E[2] - pv[2]), kk[t][3] * __builtin_amdgcn_exp2f(E[3] - pv[3]));
                *(LAS u32x2*)(base + ((2 + dir) * 64 + t) * TST) = wk;
            }
        }
        if constexpr (!G3) { if (tg == 0) *(f32x4*)(F_DECAY + ((dir ? chainb : chainf) * NCH + (dir ? idxb : idxf)) * 48 + 4 * dg) = (f32x4){__builtin_amdgcn_exp2f(E[0]), __builtin_amdgcn_exp2f(E[1]), __builtin_amdgcn_exp2f(E[2]), __builtin_amdgcn_exp2f(E[3])}; }
    }
    __syncthreads();
}
__device__ __forceinline__ void gla_g1_unit(const Frame& F, int l, int b, int h, int cc) {
    int m0, rowpos, idxf, idxb; bool lat; gla_chunk_info(b, cc, m0, lat, rowpos, idxf, idxb);
    gla_stage<false>(F, l, b, h, m0, lat, rowpos, idxf, idxb);
    const int lane = F.lane, w = F.wave, g = lane >> 4, c = lane & 15;
    const size_t chainf = ((size_t)(0 * 16 + b) * 4 + h), chainb = ((size_t)(1 * 16 + b) * 4 + h);
    const int q = c >> 2, p = c & 3;
    for (int T = w; T < 36; T += 8) { const int dir = T / 18, rem = T % 18, dt = rem / 6, et = rem % 6;
        const LAS unsigned char* KH = F.lds + GB_T + (2 + dir) * 64 * TST; const LAS unsigned char* Vb = F.lds + GB_V;
        f32x4 acc = (f32x4){0.f, 0.f, 0.f, 0.f};
#pragma unroll
        for (int ks = 0; ks < 2; ++ks) { const int tr0 = 32 * ks + 8 * g + q;
            const bf16x8 ka = tr_pair(KH + tr0 * TST + (16 * dt + 4 * p) * 2, KH + (tr0 + 4) * TST + (16 * dt + 4 * p) * 2);
            const bf16x8 vb = tr_pair(Vb + tr0 * VST + (16 * et + 4 * p) * 2, Vb + (tr0 + 4) * VST + (16 * et + 4 * p) * 2);
            acc = __builtin_amdgcn_mfma_f32_16x16x32_bf16(ka, vb, acc, 0, 0, 0); }
        bf16* gp = F_GST + ((dir ? chainb : chainf) * NCH + (dir ? idxb : idxf)) * 4608 + (size_t)(16 * dt + 4 * g) * 96 + 16 * et + c;
#pragma unroll
        for (int j = 0; j < 4; ++j) gp[j * 96] = (bf16)(cvt_pk_bf16(acc[j], 0.f) & 0xffffu); }
    __syncthreads();
}
__device__ __forceinline__ void phase_gla_g2(const Frame& F) {
    const int n = 2 * 16 * 4 * 2304;
    for (int i = F.bid * 512 + F.tid; i < n; i += F.G * 512) { const int chain = i / 2304, de2 = i % 2304, d = de2 / 48;
        unsigned* base = (unsigned*)(F_GST + (size_t)chain * NCH * 4608) + de2; const float* dc = F_DECAY + (size_t)chain * NCH * 48 + d;
        unsigned tv[NCH]; float dv[NCH];
#pragma unroll
        for (int c = 0; c < NCH; ++c) { tv[c] = base[(size_t)c * 2304]; dv[c] = dc[c * 48]; }
        float r0 = 0.f, r1 = 0.f;
#pragma unroll
        for (int c = 0; c < NCH; ++c) { const float t0 = bflo(tv[c]), t1 = bfhi(tv[c]); tv[c] = cvt_pk_bf16(r0, r1); r0 = dv[c] * r0 + t0; r1 = dv[c] * r1 + t1; }
#pragma unroll
        for (int c = 0; c < NCH; ++c) base[(size_t)c * 2304] = tv[c]; }
}
__device__ __forceinline__ void gla_g3_unit(const Frame& F, int l, int b, int h, int cc) {
    LAS float* ssx = (LAS float*)(F.lds + GB_X);
    int m0, rowpos, idxf, idxb; bool lat; gla_chunk_info(b, cc, m0, lat, rowpos, idxf, idxb);
    gla_stage<true>(F, l, b, h, m0, lat, rowpos, idxf, idxb);
    const int lane = F.lane, w = F.wave, g = lane >> 4, c = lane & 15;
    const int tt = w & 3, eh = w >> 2, q = c >> 2, p = c & 3;
    const int mrow = m0 + 16 * tt + c; const float* gn = inptr(F, 13) + l * 384 + h * 96;
    u32x2 gtv[3]; f32x4 gnv[3];
#pragma unroll
    for (int k = 0; k < 3; ++k) { const int e = 16 * (3 * eh + k) + 4 * g; gtv[k] = *(const u32x2*)(F_PX + (size_t)mrow * NPX + C_GG + h * 96 + e); gnv[k] = *(const f32x4*)(gn + e); }
    const LAS unsigned char* QFb = F.lds + GB_T; const LAS unsigned char* QBb = QFb + 64 * TST; const LAS unsigned char* KFb = QFb + 128 * TST; const LAS unsigned char* KBb = QFb + 192 * TST;
    const bf16x8 qf0 = *(const LAS bf16x8*)(QFb + (16 * tt + c) * TST + 16 * g), qf1 = *(const LAS bf16x8*)(QFb + (16 * tt + c) * TST + 64 + 16 * g);
    const bf16x8 qb0 = *(const LAS bf16x8*)(QBb + (16 * tt + c) * TST + 16 * g), qb1 = *(const LAS bf16x8*)(QBb + (16 * tt + c) * TST + 64 + 16 * g);
    f32x4 at[4];
#pragma unroll
    for (int si = 0; si < 4; ++si) {
        f32x4 zf = (f32x4){0.f, 0.f, 0.f, 0.f}, zb = zf;
        if (si <= tt) { const bf16x8 k0 = *(const LAS bf16x8*)(KFb + (16 * si + c) * TST + 16 * g), k1 = *(const LAS bf16x8*)(KFb + (16 * si + c) * TST + 64 + 16 * g);
            zf = __builtin_amdgcn_mfma_f32_16x16x32_bf16(k0, qf0, zf, 0, 0, 0); zf = __builtin_amdgcn_mfma_f32_16x16x32_bf16(k1, qf1, zf, 0, 0, 0); }
        if (si >= tt) { const bf16x8 k0 = *(const LAS bf16x8*)(KBb + (16 * si + c) * TST + 16 * g), k1 = *(const LAS bf16x8*)(KBb + (16 * si + c) * TST + 64 + 16 * g);
            zb = __builtin_amdgcn_mfma_f32_16x16x32_bf16(k0, qb0, zb, 0, 0, 0); zb = __builtin_amdgcn_mfma_f32_16x16x32_bf16(k1, qb1, zb, 0, 0, 0); }
        if (si == tt) {
#pragma unroll
            for (int j = 0; j < 4; ++j) { const int sl = 4 * g + j; at[si][j] = (sl <= c ? zf[j] : 0.f) + (sl >= c ? zb[j] : 0.f); } }
        else at[si] = zf + zb;
    }
    f32x4 o[3];
#pragma unroll
    for (int k = 0; k < 3; ++k) o[k] = (f32x4){0.f, 0.f, 0.f, 0.f};
    const LAS unsigned char* Vb = F.lds + GB_V; const LAS unsigned char* SFb = F.lds + GB_SF; const LAS unsigned char* SBb = F.lds + GB_SB;
#pragma unroll
    for (int ks = 0; ks < 2; ++ks) {
        bf16x8 pb; { u32x4 pw = (u32x4){cvt_pk_bf16(at[2 * ks][0], at[2 * ks][1]), cvt_pk_bf16(at[2 * ks][2], at[2 * ks][3]), cvt_pk_bf16(at[2 * ks + 1][0], at[2 * ks + 1][1]), cvt_pk_bf16(at[2 * ks + 1][2], at[2 * ks + 1][3])}; pb = __builtin_bit_cast(bf16x8, pw); }
#pragma unroll
        for (int k = 0; k < 3; ++k) { const int et = 3 * eh + k;
            const bf16x8 va = tr_pair(Vb + (32 * ks + 4 * g + q) * VST + (16 * et + 4 * p) * 2, Vb + (32 * ks + 16 + 4 * g + q) * VST + (16 * et + 4 * p) * 2);
            o[k] = __builtin_amdgcn_mfma_f32_16x16x32_bf16(va, pb, o[k], 0, 0, 0); }
    }
#pragma unroll
    for (int kd = 0; kd < 2; ++kd) {
#pragma unroll
        for (int k = 0; k < 3; ++k) { const int et = 3 * eh + k;
            const bf16x8 sa = tr_pair(SFb + (32 * kd + 8 * g + q) * VST + (16 * et + 4 * p) * 2, SFb + (32 * kd + 8 * g + 4 + q) * VST + (16 * et + 4 * p) * 2);
            o[k] = __builtin_amdgcn_mfma_f32_16x16x32_bf16(sa, kd ? qf1 : qf0, o[k], 0, 0, 0);
            const bf16x8 sb = tr_pair(SBb + (32 * kd + 8 * g + q) * VST + (16 * et + 4 * p) * 2, SBb + (32 * kd + 8 * g + 4 + q) * VST + (16 * et + 4 * p) * 2);
            o[k] = __builtin_amdgcn_mfma_f32_16x16x32_bf16(sb, kd ? qb1 : qb0, o[k], 0, 0, 0); }
    }
    float ss = 0.f;
#pragma unroll
    for (int k = 0; k < 3; ++k) ss += (o[k][0] * o[k][0] + o[k][1] * o[k][1]) + (o[k][2] * o[k][2] + o[k][3] * o[k][3]);
    ss += shx(ss, 16, lane); ss += shx(ss, 32, lane);
    if (g == 0) ssx[w * 16 + c] = ss;
    __syncthreads();
    const float tot = ssx[w * 16 + c] + ssx[(w ^ 4) * 16 + c];
    const float rstd = 1.0f / sqrtf(tot * (1.0f / 96.0f) + EPS);
    const int m = mrow;
#pragma unroll
    for (int k = 0; k < 3; ++k) { const int e = 16 * (3 * eh + k) + 4 * g;
        const u32x2 gt = gtv[k]; const f32x4 gv = gnv[k];
        *(unsigned*)(F_MIX + (size_t)m * D + h * 96 + e) = pk4_fp8(o[k][0] * rstd * gv[0] * silu_f(bflo(gt.x)), o[k][1] * rstd * gv[1] * silu_f(bfhi(gt.x)), o[k][2] * rstd * gv[2] * silu_f(bflo(gt.y)), o[k][3] * rstd * gv[3] * silu_f(bfhi(gt.y))); }
    __syncthreads();
}

__device__ __forceinline__ void phase_final(const Frame& F) {
    const int gw = F.bid * 8 + F.wave, NGW = F.G * 8, lane = F.lane;
    f32x4 gm[4];
#pragma unroll
    for (int j = 0; j < 4; ++j) gm[j] = *(const f32x4*)(inptr(F, 25) + 4 * lane + 256 * j);
    moe_tilebase_to_lds(F, DEPTH - 1);
    for (int m = gw; m < ML; m += NGW) {
        const int b = m >> 11; float* xr = F.out + (size_t)m * D; const bf16* xb = F_XB + (size_t)m * D;
        f32x4 v[4];
#pragma unroll
        for (int j = 0; j < 4; ++j) v[j] = bf4(*(const u32x2*)(xb + 4 * lane + 256 * j));
        const float* g5 = F_MOD + ((size_t)(DEPTH - 1) * 17 + b) * 6144 + 5 * 1024;
        const float w0 = F_SLOTW[2 * m] * 0.0625f, w1 = F_SLOTW[2 * m + 1] * 0.0625f;
        const fp8* y0 = F_YBUF + (size_t)moe_slot_row(F, 2 * m) * D; const fp8* y1 = F_YBUF + (size_t)moe_slot_row(F, 2 * m + 1) * D;
        float ss = 0.f;
#pragma unroll
        for (int j = 0; j < 4; ++j) { const f32x4 a = fp84(*(const unsigned*)(y0 + 4 * lane + 256 * j)), c = fp84(*(const unsigned*)(y1 + 4 * lane + 256 * j)); const f32x4 g = *(const f32x4*)(g5 + 4 * lane + 256 * j);
            v[j] += g * (a * w0 + c * w1);
            ss += (v[j][0] * v[j][0] + v[j][1] * v[j][1]) + (v[j][2] * v[j][2] + v[j][3] * v[j][3]); }
        const float rstd = 1.0f / sqrtf(wave_sum(ss, lane) * (1.0f / D) + EPS);
#pragma unroll
        for (int j = 0; j < 4; ++j) *(f32x4*)(xr + 4 * lane + 256 * j) = v[j] * rstd * gm[j];
    }
}

constexpr int NPL = 9, NPHASE = 1 + DEPTH * NPL + 1;
struct Args { const float* in[26]; float* out; unsigned char* ws; int ph_lo, ph_hi; };
#define IN(k) (lo <= (k) && (k) < hi)
#if MK_PER_PHASE
#define SEAM(k) do { } while (0)
#else
#define SEAM(k) do { if (IN(k) && IN((k) + 1)) { XcdBarrier _bb = bar; GAS unsigned* _bp = (GAS unsigned*)(args.ws + WS_CTL) + CW_BAR; asm volatile("" : "+s"(_bp)); _bb.bar = (unsigned*)_bp; xcd_barrier(_bb); if (DUP & 8192) xcd_barrier(_bb); } } while (0)
#endif
#define FRESH() do { int _t = threadIdx.x; asm volatile("" : "+v"(_t)); F.tid = _t; F.lane = _t & 63; F.wave = __builtin_amdgcn_readfirstlane(_t >> 6); \
        GAS unsigned char* _w = (GAS unsigned char*)args.ws; GAS float* _o = (GAS float*)args.out; int _g = gridDim.x, _b = blockIdx.x; asm volatile("" : "+s"(_w), "+s"(_o), "+s"(_g), "+s"(_b)); F.ws = (unsigned char*)_w; F.out = (float*)_o; F.G = _g; F.bid = _b; } while (0)

template <int l>
__device__ __forceinline__ void layer_body(Frame& F, const Args& args, const int lo, const int hi, const XcdBarrier& bar) {
    constexpr int pb = 1 + l * NPL; constexpr bool lastl = (l == DEPTH - 1);
    if (IN(pb + 0) && (EN & 2)) { FRESH(); if (DUP & 2) { phase_norm1<true>(F, l); __syncthreads(); } phase_norm1(F, l); router_fold(F, l); } SEAM(pb + 0);
    if (IN(pb + 1) && (EN & 4)) { FRESH(); pg8::Gemm g{F_HX8, F_WIN + (size_t)l * NPX * D, D, 0x79797979}; pg8::StaticOrder S; S.init(MT, NPX, F.G, F.bid); EpiPx E{F_PX, F.ws};
        pg8::gemm_phase<EpiPx, pg8::StaticOrder, true, false, true>(F.lds, g, S, E); if (DUP & 4) pg8::gemm_phase<EpiPx, pg8::StaticOrder, true, false, true>(F.lds, g, S, E); } SEAM(pb + 1);
    if (IN(pb + 2)) {
        XcdBarrier sb = bar; { GAS unsigned* _bp = (GAS unsigned*)(args.ws + WS_CTL) + CW_BAR; asm volatile("" : "+s"(_bp)); sb.bar = (unsigned*)_bp; }
        GAS unsigned* _sp = (GAS unsigned*)(args.ws + WS_CTL) + CW_SPL + 4096 * l; asm volatile("" : "+s"(_sp)); unsigned* slotA = (unsigned*)_sp; unsigned* slotB = slotA + 2048;
#define MIX_CONV(k) do { if constexpr (l == 0) { if ((int)(F.bid % 5) == (k)) { FRESH(); __syncthreads(); moe_convert(F, 0, F.bid, F.G); __syncthreads(); } } } while (0)
        MIX_CONV(0);
        FRESH();
        if (EN & 8) for (int rep = 0; rep < ((DUP & 8) ? 2 : 1); ++rep)
        for (int u = F.bid; u < 16 * 4 * NCH; u += F.G) { const int cc = u % NCH, bh = u / NCH; gla_g1_unit(F, l, bh >> 2, bh & 3, cc); }
        xcd_arrive(sb, slotA);
        MIX_CONV(1);
        FRESH();
        if (EN & 16) for (int rep = 0; rep < ((DUP & 16) ? 2 : 1); ++rep)
        if (F.G == 256) {
            na_latent_phase(F, l);
        } else
        for (int u = F.bid; u < 16 * 6 * 32; u += F.G) { const int r = u & 31, bh = u >> 5; na_unit(F, l, 0, bh / 6, bh % 6, r); }
        if ((EN & 16) && !lastl) for (int u = F.bid; u < 16 * 6 * 4; u += F.G) { const int qb = u & 3, bh = u >> 2; na_unit(F, l, 1, bh / 6, bh % 6, qb); }
        MIX_CONV(2);
        xcd_wait(sb, slotA);
        if (EN & 64) { FRESH(); phase_gla_g2(F); }
        xcd_arrive(sb, slotB);
        MIX_CONV(3);
        FRESH();
        if (EN & 32) for (int rep = 0; rep < ((DUP & 32) ? 2 : 1); ++rep)
        for (int u = F.bid; u < 16 * 64; u += F.G) conv_unit(F, l, (u >> 6) * 2048, 2048, (u & 63) * 32);
        if ((EN & 32) && !lastl) for (int u = F.bid; u < 16 * 8; u += F.G) conv_unit(F, l, ML + (u >> 3) * 256, 256, (u & 7) * 32);
        MIX_CONV(4);
#undef MIX_CONV
        xcd_wait(sb, slotB);
        if (EN & 128) { FRESH(); for (int rep = 0; rep < ((DUP & 128) ? 2 : 1); ++rep) for (int u = F.bid; u < 16 * 4 * NCH; u += F.G) { const int cc = u % NCH, bh = u / NCH; if (lastl && cc < 4) continue; gla_g3_unit(F, l, bh >> 2, bh & 3, cc); } }
    } SEAM(pb + 4);
    if (IN(pb + 5) && (EN & 256)) { FRESH(); pg8::Gemm g{F_MIX, F_WOUT + (size_t)l * D * D, D, 0x79797979}; SplitOrder S; S.base.init(lastl ? ML : MT, D, F.G, F.bid);
        EpiResid<l == 0> E{inptr(F, 0), inptr(F, 2), F_XB, F_MOD + (size_t)l * 17 * 6144};
        int split = 1 << 20;
        if constexpr (!lastl) { if (F.G == 256 && F.bid >= 64) split = (F.bid - 64) % 3; }
        S.i0 = 0; S.i1 = split;
        pg8::gemm_phase<EpiResid<l == 0>, SplitOrder, true, false, true>(F.lds, g, S, E);
        if constexpr (!lastl) {
            if (F.G == 256) { if (F.bid >= 64) { __syncthreads(); moe_convert(F, l + 1, F.bid - 64, 192); } } else moe_convert(F, l + 1, F.bid, F.G);
            if (split < 2) { __syncthreads(); S.i0 = split; S.i1 = 1 << 20; pg8::gemm_phase<EpiResid<l == 0>, SplitOrder, true, false, true>(F.lds, g, S, E); } } } SEAM(pb + 5);
    if (IN(pb + 6) && (EN & 512)) { FRESH(); phase_norm2_router(F, l); } SEAM(pb + 6);
    if (IN(pb + 7) && (EN & 1024)) { FRESH(); MoeOrder S; moe_setup(F, l, S, 8); pg8::Gemm g{F_HX8, F_WGU + (size_t)l * NE * 2048 * D, D, 0x79797979}; EpiSwiGLU E{F_ACT};
        pg8::gemm_phase<EpiSwiGLU, MoeOrder, true, true, true>(F.lds, g, S, E); if (DUP & 1024) pg8::gemm_phase<EpiSwiGLU, MoeOrder, true, true, true>(F.lds, g, S, E); } SEAM(pb + 7);
    if (IN(pb + 8) && (EN & 2048)) { FRESH(); MoeOrder S; moe_setup(F, l, S, 4); pg8::Gemm g{F_ACT, F_WD + (size_t)l * NE * D * D, D, 0x7d7d7d7d};     EpiYrow E{F_YBUF};
        pg8::gemm_phase<EpiYrow, MoeOrder, true, false, true>(F.lds, g, S, E); if (DUP & 2048) pg8::gemm_phase<EpiYrow, MoeOrder, true, false, true>(F.lds, g, S, E); } SEAM(pb + 8);
}

__global__ void __launch_bounds__(512, 2) fwd_kernel(Args args) {
    extern __shared__ __attribute__((aligned(16))) unsigned char lds_raw[];
    Frame F;
    F.lds = (LAS unsigned char*)lds_raw;
    F.tid = threadIdx.x; F.lane = F.tid & 63; F.wave = __builtin_amdgcn_readfirstlane(F.tid >> 6); F.G = gridDim.x; F.bid = blockIdx.x;
    F.out = args.out; F.ws = args.ws;
    if (F.tid < 26) { const unsigned long long p = (unsigned long long)args.in[F.tid]; LAS unsigned* t = (LAS unsigned*)(F.lds + LDS_PTR) + 2 * F.tid; t[0] = (unsigned)p; t[1] = (unsigned)(p >> 32); }
    volatile LAS unsigned* MISC = (volatile LAS unsigned*)(F.lds + LDS_MISC);
    if (F.tid < 64) MISC[F.tid] = 0u;
    __syncthreads();
#if MK_PER_PHASE
    XcdBarrier bar; bar.bar = nullptr; bar.x = 0; bar.st = nullptr;
#else
    XcdBarrier bar = xcd_barrier_post(F_CTL + CW_BAR, MISC + 8);
#endif
    const int lo = args.ph_lo, hi = args.ph_hi;
    if (IN(0) && (EN & 1)) { FRESH(); phase_prologue(F); if (DUP & 1) { __syncthreads(); phase_prologue(F); } } SEAM(0);
    layer_body<0>(F, args, lo, hi, bar);
    layer_body<1>(F, args, lo, hi, bar);
    layer_body<2>(F, args, lo, hi, bar);
    layer_body<3>(F, args, lo, hi, bar);
    if (IN(NPHASE - 1) && (EN & 4096)) { FRESH(); phase_final(F); }
}
#undef IN
#undef SEAM
#undef FRESH

extern "C" void kernel_launch(void* const* d_in, const int* in_sizes, int n_in, void* d_out, int out_size, void* d_ws, size_t ws_size, hipStream_t stream) {
    static int grid = 0;
    if (grid == 0) {
        if (n_in != 26 || out_size != ML * D || ws_size < WS_END) { fprintf(stderr, "kernel_launch: unexpected problem shape (n_in %d out %d ws %zu)\n", n_in, out_size, ws_size); grid = -1; return; }
        int dev = 0, cus = 0, per_cu = 0;
        if (hipGetDevice(&dev) != hipSuccess || hipDeviceGetAttribute(&cus, hipDeviceAttributeMultiprocessorCount, dev) != hipSuccess) { grid = -1; return; }
        if (hipFuncSetAttribute((const void*)fwd_kernel, hipFuncAttributeMaxDynamicSharedMemorySize, LDS_BYTES) != hipSuccess) { fprintf(stderr, "kernel_launch: hipFuncSetAttribute failed\n"); grid = -1; return; }
        if (hipOccupancyMaxActiveBlocksPerMultiprocessor(&per_cu, (const void*)fwd_kernel, 512, LDS_BYTES) != hipSuccess || per_cu < 1) { fprintf(stderr, "kernel_launch: occupancy query says %d\n", per_cu); }
        (void)hipGetLastError();
        grid = cus;
    }
    if (grid < 0) return;
    (void)hipMemsetAsync((char*)d_ws + WS_CTL, 0, CTL_ZERO_BYTES, stream);
    Args a{};
    for (int i = 0; i < 26; ++i) a.in[i] = (const float*)d_in[i];
    a.out = (float*)d_out; a.ws = (unsigned char*)d_ws;
#if MK_PER_PHASE
    for (int p = 0; p < NPHASE; ++p) { a.ph_lo = p; a.ph_hi = p + 1; hipLaunchKernelGGL(fwd_kernel, dim3(grid), dim3(512), LDS_BYTES, stream, a); }
#else
    a.ph_lo = 0; a.ph_hi = NPHASE; hipLaunchKernelGGL(fwd_kernel, dim3(grid), dim3(512), LDS_BYTES, stream, a);
#endif
}
```

```cpp
#include <hip/hip_runtime.h>
#include <cstdio>
#include <cstdint>

#ifndef EN
#define EN 0xffff
#endif
#ifndef DUP
#define DUP 0
#endif
#ifndef MK_PER_PHASE
#define MK_PER_PHASE 0
#endif

#define GAS __attribute__((address_space(1)))
#define LAS __attribute__((address_space(3)))
typedef unsigned short bf16;
typedef float f32x4 __attribute__((ext_vector_type(4)));
typedef float f32x2 __attribute__((ext_vector_type(2)));
typedef short bf16x8 __attribute__((ext_vector_type(8)));
typedef short s16x4 __attribute__((ext_vector_type(4)));
typedef unsigned u32x4 __attribute__((ext_vector_type(4)));
typedef unsigned u32x2 __attribute__((ext_vector_type(2)));
typedef int i32x8 __attribute__((ext_vector_type(8)));
typedef int i32x4 __attribute__((ext_vector_type(4)));
typedef unsigned char fp8;

constexpr int D = 1024, NBATCH = 16, SEQ = 2048, CTXL = 256, DEPTH = 4;
constexpr int ML = NBATCH * SEQ, MC = NBATCH * CTXL, MT = ML + MC;
constexpr int NIN = 2848, NPX = 3072;
constexpr int C_GQ = 0, C_GK = 192, C_GV = 384, C_GG = 768, C_GA = 1152, C_NQ = 1184, C_NK = 1568, C_NV = 1952, C_CV = 2336, C_CG = 2592;
constexpr int NE = 16, NSLOT = 2 * MT;
constexpr int NCH = 36;
constexpr float EPS = 1e-6f;

constexpr size_t MiB = 1u << 20;
constexpr size_t WS_CTL = 0, CTL_ZERO_BYTES = 1 * MiB;
constexpr size_t WS_MOD = 1 * MiB;
constexpr size_t WS_ROPE = 3 * MiB;
constexpr size_t WS_DECAY = 4 * MiB;
constexpr size_t WS_WIN = 5 * MiB;
constexpr size_t WS_WOUT = 29 * MiB;
constexpr size_t WS_WGU = 37 * MiB;
constexpr size_t WS_XB = 165 * MiB;
constexpr size_t WS_RWP = 237 * MiB;
constexpr size_t WS_WD = 293 * MiB;
constexpr size_t WS_HX = 421 * MiB;
constexpr size_t WS_PX = 493 * MiB;
constexpr size_t WS_MIX = 709 * MiB;
constexpr size_t WS_GST = 781 * MiB;
constexpr size_t WS_XC = 862 * MiB;
constexpr size_t WS_LIST = 878 * MiB;
constexpr size_t WS_PV = 881 * MiB;
constexpr size_t WS_END = 936 * MiB;
constexpr int CW_TMO = 0, CW_BAR = 4096, CW_MOE = 8192, CW_SPL = 24576;

constexpr int SCR_BYTES = 139264;
constexpr int LDS_MISC = SCR_BYTES;
constexpr int LDS_PTR = LDS_MISC + 256;
constexpr int LDS_MOE = LDS_PTR + 256;
constexpr int LDS_ROWS = LDS_MOE + 256;
constexpr int MAXU = 12;
constexpr int LDS_BYTES = 152576;
static_assert(LDS_ROWS + MAXU * 1024 <= LDS_BYTES, "LDS map");

typedef __bf16 bf16x2_t __attribute__((ext_vector_type(2)));
__device__ __forceinline__ unsigned cvt_pk_bf16(float lo, float hi) { const bf16x2_t v = {(__bf16)lo, (__bf16)hi}; return __builtin_bit_cast(unsigned, v); }
__device__ __forceinline__ float bflo(unsigned w) { return __uint_as_float(w << 16); }
__device__ __forceinline__ float bfhi(unsigned w) { return __uint_as_float(w & 0xffff0000u); }
__device__ __forceinline__ f32x4 bf4(u32x2 w) { return (f32x4){bflo(w.x), bfhi(w.x), bflo(w.y), bfhi(w.y)}; }
__device__ __forceinline__ float bf2f(bf16 b) { return __uint_as_float((unsigned)b << 16); }
__device__ __forceinline__ float shx(float v, int o, int lane) { return __int_as_float(__builtin_amdgcn_ds_bpermute((lane ^ o) << 2, __float_as_int(v))); }
__device__ __forceinline__ float wave_sum(float v, int lane) {
#pragma unroll
    for (int o = 1; o < 64; o <<= 1) v += shx(v, o, lane);
    return v;
}
__device__ __forceinline__ f32x4 fp84(unsigned w) { const auto lo = __builtin_amdgcn_cvt_pk_f32_fp8((int)w, false); const auto hi = __builtin_amdgcn_cvt_pk_f32_fp8((int)w, true); return (f32x4){lo[0], lo[1], hi[0], hi[1]}; }
__device__ __forceinline__ unsigned pk4_fp8(float a, float b, float c, float d) { int p = __builtin_amdgcn_cvt_pk_fp8_f32(a, b, 0, false); p = __builtin_amdgcn_cvt_pk_fp8_f32(c, d, p, true); return (unsigned)p; }
__device__ __forceinline__ float silu_f(float x) { return x * __builtin_amdgcn_rcpf(1.0f + __expf(-x)); }
__device__ __forceinline__ float sigmoid_f(float x) { return __builtin_amdgcn_rcpf(1.0f + __expf(-x)); }

namespace pg8 {
constexpr int BM = 256, BK = 64, HALF = 128, HTB = HALF * BK * 2, STAGE_BYTES = 8 * HTB, NXCD = 8, WGM = 8;
__host__ __device__ __forceinline__ int lds_byte(int r, int c) { const int st = (r >> 4) * 2 + (c >> 5), rr = r & 15, cc = c & 31, ob = rr * 64 + cc * 2; return st * 1024 + (ob ^ (((ob >> 9) & 1) << 5)); }
__host__ __device__ __forceinline__ void stage_rc(int b, int& R, int& C) { const int st = b / 1024, sb = b % 1024, swz = sb ^ (((sb >> 9) & 1) << 5); R = (st >> 1) * 16 + swz / 64; C = (st & 1) * 32 + (swz % 64) / 2; }
__host__ __device__ __forceinline__ int perm32(int rho) { const int n = rho >> 4, i = rho & 15; return 8 * (i >> 2) + 4 * n + (i & 3); }

struct Unit { int pm, pn, aux; };
struct Gemm { const void* A; const void* Bt; int RB; };

struct StaticOrder {
    int nM, nN, nwg, G, c;
    __device__ void init(int M, int N, int G_, int c_) { nM = M / BM; nN = N / BM; nwg = nM * nN; G = G_; c = c_; }
    __device__ bool next(int i, Unit& u) const {
        const long L = (long)i * G + c; if (L >= nwg) return false;
        int wgid = (int)L; { const int q = nwg / NXCD, r = nwg % NXCD, xcd = wgid % NXCD, off = wgid / NXCD; wgid = (xcd < r ? xcd * (q + 1) : r * (q + 1) + (xcd - r) * q) + off; }
        const int nig = WGM * nN, gid = wgid / nig, fm = gid * WGM, gsz = (nM - fm) < WGM ? (nM - fm) : WGM;
        u.pm = fm + ((wgid % nig) % gsz); u.pn = (wgid % nig) / gsz; u.aux = i; return true;
    }
    __device__ __forceinline__ unsigned row_off(const Unit&, int) const { return 0u; }
};

template <class Epi, class Sched, bool ALIGN_EPI, bool GATHER, bool FP8 = false>
__device__ __forceinline__ void gemm_phase(LAS unsigned char* lds, const Gemm g, const Sched& S, const Epi& E) {
    int tid_ = threadIdx.x; asm volatile("" : "+v"(tid_));
    const int tid = tid_, wid = __builtin_amdgcn_readfirstlane(tid >> 6), lane = tid & 63, wr = wid >> 2, wc = wid & 3, fr = lane & 15, fq = lane >> 4;
    const int RB = g.RB; int nt_ = RB / (BK * 2); asm volatile("" : "+s"(nt_)); const int nt = nt_;
    unsigned voffB[2];
#pragma unroll
    for (int i = 0; i < 2; ++i) { int R, C; stage_rc(tid * 16 + i * 8192, R, C); const int Rb = Epi::PERM ? ((R & ~31) + perm32(R & 31)) : R;
        voffB[i] = (unsigned)(Rb * RB + C * 2); }
    const size_t kstep = (size_t)(BK * 2);
    const size_t hstep = (size_t)HALF * RB;
    const size_t ahs = GATHER ? (size_t)0 : hstep;
    const size_t tstep = 2 * hstep;
    const unsigned ldsw = (unsigned)wid * 1024u;
    const int aoff = lds_byte(wr * 64 + fr, fq * 8), boff = lds_byte(wc * 32 + fr, fq * 8);
#define PG8_SA(b, h) (((b) * 2 + (h)) * HTB)
#define PG8_SB(b, h) ((4 + (b) * 2 + (h)) * HTB)
#define PG8_STAGE(bufoff, gbase, voff) do { _Pragma("unroll") for (int _i = 0; _i < 2; ++_i) \
        __builtin_amdgcn_global_load_lds((const unsigned*)((const char*)(gbase) + (voff)[_i]), (LAS unsigned*)(lds + (bufoff) + ldsw + _i * 8192), 16, 0, 0); } while (0)
#define PG8_LDA(dst, b, h) do { if constexpr (FP8) { _Pragma("unroll") for (int m = 0; m < 4; ++m) { const i32x4 _lo = *(const LAS i32x4*)(lds + PG8_SA(b, h) + aoff + m * 2048), _hi = *(const LAS i32x4*)(lds + PG8_SA(b, h) + aoff + m * 2048 + 1024); \
            dst##8[m] = __builtin_shufflevector(_lo, _hi, 0, 1, 2, 3, 4, 5, 6, 7); } } \
        else { _Pragma("unroll") for (int m = 0; m < 4; ++m) _Pragma("unroll") for (int k = 0; k < 2; ++k) dst[m][k] = *(const LAS bf16x8*)(lds + PG8_SA(b, h) + aoff + m * 2048 + k * 1024); } } while (0)
#define PG8_LDB(dst, b, h) do { if constexpr (FP8) { _Pragma("unroll") for (int n = 0; n < 2; ++n) { const i32x4 _lo = *(const LAS i32x4*)(lds + PG8_SB(b, h) + boff + n * 2048), _hi = *(const LAS i32x4*)(lds + PG8_SB(b, h) + boff + n * 2048 + 1024); \
            dst##8[n] = __builtin_shufflevector(_lo, _hi, 0, 1, 2, 3, 4, 5, 6, 7); } } \
        else { _Pragma("unroll") for (int n = 0; n < 2; ++n) _Pragma("unroll") for (int k = 0; k < 2; ++k) dst[n][k] = *(const LAS bf16x8*)(lds + PG8_SB(b, h) + boff + n * 2048 + k * 1024); } } while (0)
#define PG8_MMA(ai, bj, At, Bt) do { __builtin_amdgcn_s_setprio(1); _Pragma("unroll") for (int m = 0; m < 4; ++m) _Pragma("unroll") for (int n = 0; n < 2; ++n) { \
        if constexpr (FP8) asm volatile("v_mfma_scale_f32_16x16x128_f8f6f4 %0, %1, %2, %0, %3, %3 op_sel_hi:[0,0,0]" : "+v"(acc[ai][bj][m][n]) : "v"(Bt##8[n]), "v"(At##8[m]), "v"(scl1));   \
        else { _Pragma("unroll") for (int k = 0; k < 2; ++k) acc[ai][bj][m][n] = __builtin_amdgcn_mfma_f32_16x16x32_bf16(Bt[n][k], At[m][k], acc[ai][bj][m][n], 0, 0, 0); } } \
        __builtin_amdgcn_s_setprio(0); } while (0)
#define PG8_WAIT_V(n) asm volatile("s_waitcnt vmcnt(" #n ")" ::: "memory")
#define PG8_WAIT_L(n) asm volatile("s_waitcnt lgkmcnt(" #n ")" ::: "memory")
#define PG8_BAR __builtin_amdgcn_s_barrier()
#define PG8_SCHED __builtin_amdgcn_sched_barrier(0)
#define PG8_SETVA(v, u) do { _Pragma("unroll") for (int _i = 0; _i < 2; ++_i) { int _R, _C; stage_rc(tid * 16 + _i * 8192, _R, _C); \
        if constexpr (GATHER) { v[0][_i] = S.row_off(u, _R) + (unsigned)_C * 2u; v[1][_i] = S.row_off(u, HALF + _R) + (unsigned)_C * 2u; } \
        else { v[0][_i] = (unsigned)(_R * RB + _C * 2); v[1][_i] = v[0][_i]; } } } while (0)
    Unit cur, nxt; int ui = 0;
    if (!S.next(0, cur)) return;
    f32x4 acc[2][2][4][2];
#pragma unroll
    for (int a = 0; a < 2; ++a)
#pragma unroll
        for (int b = 0; b < 2; ++b)
#pragma unroll
            for (int m = 0; m < 4; ++m)
#pragma unroll
                for (int n = 0; n < 2; ++n) acc[a][b][m][n] = (f32x4){0.f, 0.f, 0.f, 0.f};
    const int scl1 = 0x7f7f7f7f;
    bf16x8 At[4][2], B0[2][2], B1[2][2]; i32x8 At8[4], B08[2], B18[2];
    unsigned vA[2][2], vAn[2][2];
    PG8_SETVA(vA, cur);
    const char* cA = GATHER ? (const char*)g.A : (const char*)g.A + (size_t)cur.pm * tstep; const char* cB = (const char*)g.Bt + (size_t)cur.pn * tstep;
    PG8_STAGE(PG8_SB(0, 0), cB, voffB); PG8_STAGE(PG8_SB(0, 1), cB + hstep, voffB); PG8_STAGE(PG8_SA(0, 0), cA, vA[0]); PG8_STAGE(PG8_SA(0, 1), cA + ahs, vA[1]);
    if (wr == 1) PG8_BAR;
    PG8_WAIT_V(2); PG8_BAR;
    PG8_STAGE(PG8_SB(1, 0), cB + kstep, voffB); PG8_STAGE(PG8_SA(1, 0), cA + kstep, vA[0]); PG8_STAGE(PG8_SB(1, 1), cB + hstep + kstep, voffB);
    PG8_WAIT_V(6); PG8_BAR;
    for (;;) {
        const bool has_next = S.next(ui + 1, nxt);
        const char* nA = GATHER ? cA : (has_next ? (const char*)g.A + (size_t)nxt.pm * tstep : cA);
        const char* nB = has_next ? (const char*)g.Bt + (size_t)nxt.pn * tstep : cB;
        if constexpr (GATHER) {
            if (has_next) { PG8_SETVA(vAn, nxt); }
            else {
#pragma unroll
                for (int h = 0; h < 2; ++h)
#pragma unroll
                    for (int i = 0; i < 2; ++i) vAn[h][i] = vA[h][i]; }
        }
#pragma unroll 1
        for (int t = 0; t < nt; t += 2) {
            const bool last = (t == nt - 2);
            const char* a1 = cA + (size_t)(t + 1) * kstep;
            const char* a2 = last ? nA : cA + (size_t)(t + 2) * kstep; const char* b2 = last ? nB : cB + (size_t)(t + 2) * kstep;
            const char* a3 = a2 + kstep; const char* b3 = b2 + kstep;
            unsigned v2[2][2];
#pragma unroll
            for (int h = 0; h < 2; ++h)
#pragma unroll
                for (int i = 0; i < 2; ++i) { if constexpr (GATHER) v2[h][i] = last ? vAn[h][i] : vA[h][i]; else v2[h][i] = vA[h][i]; }
            PG8_LDB(B0, 0, 0); PG8_LDB(B1, 0, 1); PG8_SCHED; PG8_LDA(At, 0, 0); PG8_STAGE(PG8_SA(1, 1), a1 + ahs, vA[1]);
            PG8_WAIT_V(8); PG8_WAIT_L(0); PG8_BAR; PG8_MMA(0, 0, At, B0); PG8_MMA(0, 1, At, B1); PG8_BAR; PG8_SCHED;
            PG8_LDA(At, 0, 1); PG8_STAGE(PG8_SB(0, 0), b2, voffB); PG8_STAGE(PG8_SB(0, 1), b2 + hstep, voffB); PG8_STAGE(PG8_SA(0, 0), a2, v2[0]);
            PG8_WAIT_V(8); PG8_WAIT_L(0); PG8_BAR; PG8_MMA(1, 0, At, B0); PG8_MMA(1, 1, At, B1); PG8_BAR; PG8_SCHED;
            PG8_LDB(B0, 1, 0); PG8_LDB(B1, 1, 1); PG8_SCHED; PG8_LDA(At, 1, 0); PG8_STAGE(PG8_SA(0, 1), a2 + ahs, v2[1]);
            PG8_WAIT_V(8); PG8_WAIT_L(0); PG8_BAR; PG8_MMA(0, 0, At, B0); PG8_MMA(0, 1, At, B1); PG8_BAR; PG8_SCHED;
            PG8_LDA(At, 1, 1); PG8_STAGE(PG8_SB(1, 0), b3, voffB); PG8_STAGE(PG8_SB(1, 1), b3 + hstep, voffB); PG8_STAGE(PG8_SA(1, 0), a3, v2[0]);
            PG8_WAIT_V(8); PG8_WAIT_L(0); PG8_BAR; PG8_MMA(1, 0, At, B0); PG8_MMA(1, 1, At, B1); PG8_BAR; PG8_SCHED;
        }
        if constexpr (ALIGN_EPI) { if (wr == 0) PG8_BAR; }
        if constexpr (FP8) asm volatile("s_nop 15\n\ts_nop 15" ::: "memory");
        E(acc, cur, wr, wc, fr, fq);
        if (!has_next) break;
#pragma unroll
        for (int a = 0; a < 2; ++a)
#pragma unroll
            for (int b = 0; b < 2; ++b)
#pragma unroll
                for (int m = 0; m < 4; ++m)
#pragma unroll
                    for (int n = 0; n < 2; ++n) acc[a][b][m][n] = (f32x4){0.f, 0.f, 0.f, 0.f};
        cur = nxt; cA = nA; cB = nB; ++ui;
        if constexpr (GATHER) {
#pragma unroll
            for (int h = 0; h < 2; ++h)
#pragma unroll
                for (int i = 0; i < 2; ++i) vA[h][i] = vAn[h][i]; }
        if constexpr (ALIGN_EPI) { if (wr == 1) PG8_BAR; }
    }
    PG8_WAIT_V(0);
    if constexpr (!ALIGN_EPI) { if (wr == 0) PG8_BAR; }
    PG8_BAR;
#undef PG8_SA
#undef PG8_SB
#undef PG8_STAGE
#undef PG8_LDA
#undef PG8_LDB
#undef PG8_MMA
#undef PG8_WAIT_V
#undef PG8_WAIT_L
#undef PG8_BAR
#undef PG8_SCHED
#undef PG8_SETVA
}
}

#define XB_TMO      128
#define XB_XCNT(j)  (256  + 64 * (j))
#define XB_XSUB(j)  (1280 + 64 * (j))
#define XB_XGEN(j)  (2304 + 64 * (j))
#define XB_TOP      3328
#define XB_TOPGEN   3392
#define XCD_BAR_WORDS 3456
#define XB_SPIN_CAP (1u << 18)
__device__ __forceinline__ unsigned xb_ld(unsigned* p)              { return __hip_atomic_load(p, __ATOMIC_RELAXED, __HIP_MEMORY_SCOPE_AGENT); }
__device__ __forceinline__ unsigned xb_add(unsigned* p, unsigned v) { return __hip_atomic_fetch_add(p, v, __ATOMIC_RELAXED, __HIP_MEMORY_SCOPE_AGENT); }
__device__ __forceinline__ unsigned xb_xcc_id() { return (unsigned)__builtin_amdgcn_s_getreg((3 << 11) | 20) & 0xFu; }
#define XB_SPIN(cond, bar) do { unsigned _sp = 0; while (cond) { __builtin_amdgcn_s_sleep(1); \
    if ((++_sp & 255u) == 0u) { if (xb_ld(&(bar)[XB_TMO])) break; if (_sp > XB_SPIN_CAP) { atomicAdd(&(bar)[XB_TMO], 1u); break; } } } } while (0)
struct XcdBarrier { unsigned* bar; unsigned x; volatile LAS unsigned* st; };
__device__ __forceinline__ XcdBarrier xcd_barrier_post(unsigned* bar, volatile LAS unsigned* st) {
    XcdBarrier b; b.bar = bar; b.x = xb_xcc_id(); b.st = st;
    if (threadIdx.x == 0) (void)xb_add(&bar[XB_XCNT(b.x)], 1u);
    return b;
}
__device__ __forceinline__ void xcd_barrier_complete(unsigned* bar, unsigned x, unsigned& nloc, unsigned& nx) {
    const unsigned G = gridDim.x * gridDim.y * gridDim.z;
    unsigned sum, cnt, mine, sp = 0u;
    for (;;) {
        sum = 0u; cnt = 0u; mine = 0u;
#pragma unroll
        for (unsigned j = 0; j < 16; ++j) { const unsigned c = xb_ld(&bar[XB_XCNT(j)]); sum += c; cnt += (c > 0u) ? 1u : 0u; mine = (j == x) ? c : mine; }
        if (sum == G) break;
        __builtin_amdgcn_s_sleep(1);
        if ((++sp & 255u) == 0u) { if (xb_ld(&bar[XB_TMO])) break; if (sp > XB_SPIN_CAP) { atomicAdd(&bar[XB_TMO], 1u); break; } }
    }
    nloc = mine > 0u ? mine : 1u; nx = cnt > 0u ? cnt : 1u;
}
__device__ __forceinline__ void xcd_barrier(const XcdBarrier& b) {
    asm volatile("s_waitcnt vmcnt(0)" ::: "memory");
    __syncthreads();
    if (threadIdx.x == 0) {
        unsigned* bar = b.bar;
        __builtin_amdgcn_s_waitcnt(0);
        unsigned nloc = b.st[0], nx = b.st[1];
        if (nloc == 0u) { xcd_barrier_complete(bar, b.x, nloc, nx); b.st[0] = nloc; b.st[1] = nx; }
        const unsigned old = xb_add(&bar[XB_XSUB(b.x)], 1u);
        const unsigned gen = old / nloc;
        if (old + 1u == (gen + 1u) * nloc) {
            __builtin_amdgcn_fence(__ATOMIC_RELEASE, "agent");
            asm volatile("s_waitcnt vmcnt(0)" ::: "memory");
            const unsigned og = xb_add(&bar[XB_TOP], 1u);
            const unsigned tg = og / nx;
            if (og + 1u == (tg + 1u) * nx) xb_add(&bar[XB_TOPGEN], 1u);
            else XB_SPIN(xb_ld(&bar[XB_TOPGEN]) == tg, bar);
            __builtin_amdgcn_fence(__ATOMIC_ACQUIRE, "agent");
            xb_add(&bar[XB_XGEN(b.x)], 1u);
            asm volatile("s_waitcnt vmcnt(0)" ::: "memory");
        } else {
            XB_SPIN(xb_ld(&bar[XB_XGEN(b.x)]) == gen, bar);
            __builtin_amdgcn_fence(__ATOMIC_ACQUIRE, "agent");
            asm volatile("s_waitcnt vmcnt(0)" ::: "memory");
        }
    }
    __syncthreads();
}
__device__ __forceinline__ void xcd_arrive(const XcdBarrier& b, unsigned* slot) {
    asm volatile("s_waitcnt vmcnt(0)" ::: "memory");
    __syncthreads();
    if (threadIdx.x == 0) {
        __builtin_amdgcn_s_waitcnt(0);
        const unsigned nloc = b.st[0];
        const unsigned old = xb_add(&slot[64 * b.x], 1u);
        if (old + 1u == nloc) {
            __builtin_amdgcn_fence(__ATOMIC_RELEASE, "agent");
            asm volatile("s_waitcnt vmcnt(0)" ::: "memory");
            xb_add(&slot[1024], 1u);
        }
    }
}
__device__ __forceinline__ void xcd_wait(const XcdBarrier& b, unsigned* slot) {
    if (threadIdx.x == 0) {
        const unsigned nx = b.st[1];
        XB_SPIN(xb_ld(&slot[1024]) < nx, b.bar);
        __builtin_amdgcn_fence(__ATOMIC_ACQUIRE, "agent");
        asm volatile("s_waitcnt vmcnt(0)" ::: "memory");
    }
    __syncthreads();
}

struct Frame {
    LAS unsigned char* lds;
    int tid, lane, wave, G, bid;
    float* out;
    unsigned char* ws;
};
__device__ __forceinline__ const float* inptr(const Frame& F, int k) {
    const LAS unsigned* t = (const LAS unsigned*)(F.lds + LDS_PTR) + 2 * k;
    const unsigned lo = __builtin_amdgcn_readfirstlane(t[0]), hi = __builtin_amdgcn_readfirstlane(t[1]);
    return (const float*)(const GAS float*)(((unsigned long long)hi << 32) | lo);
}
#define WSP(T, off) ((T*)(F.ws + (off)))
#define F_CTL WSP(unsigned, WS_CTL)
#define F_MOD WSP(float, WS_MOD)
#define F_ROPE WSP(float, WS_ROPE)
#define F_DECAY WSP(float, WS_DECAY)
#define F_WIN WSP(fp8, WS_WIN)
#define F_WOUT WSP(fp8, WS_WOUT)
#define F_WGU WSP(fp8, WS_WGU)
#define F_WD WSP(fp8, WS_WD)
#define F_HX WSP(bf16, WS_HX)
#define F_PX WSP(bf16, WS_PX)
#define F_ACT WSP(fp8, WS_PX)
#define F_HX8 WSP(fp8, WS_HX)
#define F_MIX WSP(fp8, WS_MIX)
#define F_YBUF WSP(fp8, WS_MIX)
#define F_PV WSP(float, WS_PV)
#define F_GST WSP(bf16, WS_GST)
#define F_XB WSP(bf16, WS_XB)
#define F_RWH WSP(bf16, WS_RWP)
#define F_RWL WSP(bf16, WS_RWP + 1 * MiB)
#define F_CB WSP(float, WS_RWP + 2 * MiB)
#define F_KNL WSP(bf16, WS_RWP + 8 * MiB)
#define F_VNL WSP(bf16, WS_RWP + 32 * MiB)
#define F_KNC WSP(bf16, WS_GST + 41 * MiB)
#define F_VNC WSP(bf16, WS_GST + 44 * MiB)
#define F_AF WSP(float, WS_RWP + 3 * MiB)
#define F_BF WSP(float, WS_RWP + 4 * MiB)
#define F_LIST WSP(int, WS_LIST)
#define F_SLOTW WSP(float, WS_LIST + 2 * MiB + 512 * 1024)
#define F_SPOS WSP(int, WS_XC)

struct EpiPx {
    static constexpr bool PERM = true;
    bf16* O; unsigned char* ws;
    __device__ __forceinline__ void operator()(const f32x4 (&acc)[2][2][4][2], const pg8::Unit& u, int wr, int wc, int fr, int fq) const {
        const int t0 = u.pm * 256, row0 = t0 + wr * 64 + fr, col0 = u.pn * 256 + wc * 32 + 8 * fq;
        const bool lat = t0 < ML; const int b = lat ? (t0 >> 11) : ((t0 - ML) >> 8); const int tb = lat ? b * 2048 : ML + b * 256;
#pragma unroll
        for (int bj = 0; bj < 2; ++bj) {
            const int cw = u.pn * 256 + bj * 128 + wc * 32;
            bf16* base; size_t rstride;
            if (cw >= C_NK && cw < C_CV) { const bool isv = cw >= C_NV; const int cc = cw - (isv ? C_NV : C_NK), h = cc >> 6, d0 = (cc & 63) + 8 * fq;
                const size_t off = lat ? (isv ? WS_RWP + 32 * MiB : WS_RWP + 8 * MiB) : (isv ? WS_GST + 44 * MiB : WS_GST + 41 * MiB);
                base = (bf16*)(ws + off) + (size_t)(b * 6 + h) * (lat ? 2048 * 64 : 256 * 64) + (size_t)(row0 - tb) * 64 + d0; rstride = 64; }
            else { base = O + (size_t)row0 * NPX + col0 + bj * 128; rstride = NPX; }
#pragma unroll
            for (int ai = 0; ai < 2; ++ai)
#pragma unroll
                for (int m = 0; m < 4; ++m) { const f32x4 v0 = acc[ai][bj][m][0] * 0.015625f, v1 = acc[ai][bj][m][1] * 0.015625f;
                    u32x4 w; w.x = cvt_pk_bf16(v0[0], v0[1]); w.y = cvt_pk_bf16(v0[2], v0[3]); w.z = cvt_pk_bf16(v1[0], v1[1]); w.w = cvt_pk_bf16(v1[2], v1[3]);
                    *(u32x4*)(base + (size_t)(ai * 128 + m * 16) * rstride) = w; }
        }
    }
};
template <bool L0>
struct EpiResid {
    static constexpr bool PERM = true;
    const float* lat_in; const float* ctx_in; bf16* xb; const float* modl;
    __device__ __forceinline__ void operator()(const f32x4 (&acc)[2][2][4][2], const pg8::Unit& u, int wr, int wc, int fr, int fq) const {
        const int t0 = u.pm * 256; const bool lat = t0 < ML; const int b = lat ? (t0 >> 11) : 16;
        const float* base = lat ? lat_in + (size_t)t0 * D : ctx_in + (size_t)(t0 - ML) * D;
        const int col0 = u.pn * 256 + wc * 32 + 8 * fq;
        const float* gate = modl + (size_t)b * 6144 + 2 * 1024 + col0;
        f32x4 gv[2][2];
#pragma unroll
        for (int bj = 0; bj < 2; ++bj)
#pragma unroll
            for (int n = 0; n < 2; ++n) gv[bj][n] = *(const f32x4*)(gate + bj * 128 + 4 * n);
#pragma unroll
        for (int ai = 0; ai < 2; ++ai)
#pragma unroll
            for (int m = 0; m < 4; ++m) { const int rr = ai * 128 + wr * 64 + m * 16 + fr; bf16* op = xb + (size_t)(t0 + rr) * D + col0;
#pragma unroll
                for (int bj = 0; bj < 2; ++bj) { f32x4 b0, b1;
                    if constexpr (L0) { b0 = *(const f32x4*)(base + (size_t)rr * D + col0 + bj * 128); b1 = *(const f32x4*)(base + (size_t)rr * D + col0 + bj * 128 + 4); }
                    else { const u32x4 w = *(const u32x4*)(op + bj * 128); b0 = (f32x4){bflo(w.x), bfhi(w.x), bflo(w.y), bfhi(w.y)}; b1 = (f32x4){bflo(w.z), bfhi(w.z), bflo(w.w), bfhi(w.w)}; }
                    const f32x4 v0 = b0 + gv[bj][0] * (acc[ai][bj][m][0] * 0.015625f), v1 = b1 + gv[bj][1] * (acc[ai][bj][m][1] * 0.015625f);
                    u32x4 o; o.x = cvt_pk_bf16(v0[0], v0[1]); o.y = cvt_pk_bf16(v0[2], v0[3]); o.z = cvt_pk_bf16(v1[0], v1[1]); o.w = cvt_pk_bf16(v1[2], v1[3]);
                    *(u32x4*)(op + bj * 128) = o; } }
    }
};
struct EpiSwiGLU {
    static constexpr bool PERM = true;
    fp8* act;
    __device__ __forceinline__ void operator()(const f32x4 (&acc)[2][2][4][2], const pg8::Unit& u, int wr, int wc, int fr, int fq) const {
        const int row0 = u.pm * 256 + wr * 64 + fr, col0 = (u.pn & 7) * 128 + wc * 32 + 8 * fq;
#pragma unroll
        for (int ai = 0; ai < 2; ++ai)
#pragma unroll
            for (int m = 0; m < 4; ++m) { fp8* rowp = act + (size_t)(row0 + ai * 128 + m * 16) * 1024 + col0;
                f32x4 r4[2];
#pragma unroll
                for (int n = 0; n < 2; ++n) { const f32x4 ag = acc[ai][0][m][n], au = acc[ai][1][m][n]; const f32x4 t = ag * (-1.4426950408889634f * 0.015625f);
                    f32x4 e; e[0] = __builtin_amdgcn_exp2f(t[0]); e[1] = __builtin_amdgcn_exp2f(t[1]); e[2] = __builtin_amdgcn_exp2f(t[2]); e[3] = __builtin_amdgcn_exp2f(t[3]);
                    const f32x4 d = e + 1.0f;
                    f32x4 rc; rc[0] = __builtin_amdgcn_rcpf(d[0]); rc[1] = __builtin_amdgcn_rcpf(d[1]); rc[2] = __builtin_amdgcn_rcpf(d[2]); rc[3] = __builtin_amdgcn_rcpf(d[3]);
                    r4[n] = (ag * au) * (rc * 0.000244140625f); }
                u32x2 w; w.x = pk4_fp8(r4[0][0], r4[0][1], r4[0][2], r4[0][3]); w.y = pk4_fp8(r4[1][0], r4[1][1], r4[1][2], r4[1][3]);
                *(u32x2*)rowp = w; }
    }
};
struct EpiYrow {
    static constexpr bool PERM = true;
    fp8* yrow;
    __device__ __forceinline__ void operator()(const f32x4 (&acc)[2][2][4][2], const pg8::Unit& u, int wr, int wc, int fr, int fq) const {
        const int row0 = u.pm * 256 + wr * 64 + fr, col0 = (u.pn & 3) * 256 + wc * 32 + 8 * fq;
#pragma unroll
        for (int ai = 0; ai < 2; ++ai)
#pragma unroll
            for (int m = 0; m < 4; ++m) { fp8* rowp = yrow + (size_t)(row0 + ai * 128 + m * 16) * 1024 + col0;
#pragma unroll
                for (int bj = 0; bj < 2; ++bj) { const f32x4 v0 = acc[ai][bj][m][0] * 0.25f, v1 = acc[ai][bj][m][1] * 0.25f;
                    u32x2 w; w.x = pk4_fp8(v0[0], v0[1], v0[2], v0[3]); w.y = pk4_fp8(v1[0], v1[1], v1[2], v1[3]);
                    *(u32x2*)(rowp + bj * 128) = w; } }
    }
};

struct SplitOrder {
    pg8::StaticOrder base; int i0, i1;
    __device__ __forceinline__ bool next(int i, pg8::Unit& u) const { return (i0 + i < i1) && base.next(i0 + i, u); }
    __device__ __forceinline__ unsigned row_off(const pg8::Unit&, int) const { return 0u; }
};
struct MoeOrder {
    const LAS int* mbase; const LAS int* rows; int NT, G, c, TM; unsigned rowbytes;
    __device__ __forceinline__ bool next(int i, pg8::Unit& u) const {
        int pnl, gm;
        if ((G & 7) == 0) { const int xcd = c & 7, j = c >> 3, q = i * (G >> 3) + j; pnl = q % NT; gm = (q / NT) * 8 + xcd; }
        else { const int L = i * G + c; pnl = L % NT; gm = L / NT; }
        if (gm >= TM) return false;
        int e = 0;
#pragma unroll
        for (int k = 1; k < 16; ++k) e += (mbase[k] <= gm) ? 1 : 0;
        u.pm = gm; u.pn = __builtin_amdgcn_readfirstlane(e) * NT + pnl; u.aux = i; return true;
    }
    __device__ __forceinline__ unsigned row_off(const pg8::Unit& u, int r) const { const int s = rows[u.aux * 256 + r]; return s < 0 ? 0u : (unsigned)(s >> 1) * rowbytes; }
};

__device__ __forceinline__ void transpose_item(const float* W, int ldw, int k0, int n0, bf16* WT, int Kd, int drow0, LAS float* scr, int lane) {
#pragma unroll 8
    for (int i = 0; i < 32; ++i) { const int kk = 2 * i + (lane >> 5); scr[kk * 33 + (lane & 31)] = W[(size_t)(k0 + kk) * ldw + n0 + (lane & 31)]; }
    asm volatile("s_waitcnt lgkmcnt(0)" ::: "memory");
    const int c = lane & 7;
#pragma unroll
    for (int j = 0; j < 4; ++j) { const int n = (lane >> 3) + 8 * j; const LAS float* s = scr + (8 * c) * 33 + n;
        u32x4 o; o.x = cvt_pk_bf16(s[0 * 33], s[1 * 33]); o.y = cvt_pk_bf16(s[2 * 33], s[3 * 33]); o.z = cvt_pk_bf16(s[4 * 33], s[5 * 33]); o.w = cvt_pk_bf16(s[6 * 33], s[7 * 33]);
        *(u32x4*)(WT + (size_t)(drow0 + n) * Kd + k0 + 8 * c) = o; }
    asm volatile("s_waitcnt lgkmcnt(0)" ::: "memory");
}
__device__ __forceinline__ void transpose_item_fp8(const float* W, int ldw, int k0, int n0, fp8* WT, int Kd, int drow0, LAS float* scr, int lane) {
    float wv[32];
#pragma unroll
    for (int i = 0; i < 32; ++i) { const int kk = 2 * i + (lane >> 5); wv[i] = W[(size_t)(k0 + kk) * ldw + n0 + (lane & 31)]; }
#pragma unroll
    for (int i = 0; i < 32; ++i) { const int kk = 2 * i + (lane >> 5); scr[kk * 33 + (lane & 31)] = wv[i] * 64.0f; }
    asm volatile("s_waitcnt lgkmcnt(0)" ::: "memory");
    const int c = lane & 3;
#pragma unroll
    for (int j = 0; j < 2; ++j) { const int n = (lane >> 2) + 16 * j; const LAS float* s = scr + (16 * c) * 33 + n;
        u32x4 o; o.x = pk4_fp8(s[0 * 33], s[1 * 33], s[2 * 33], s[3 * 33]); o.y = pk4_fp8(s[4 * 33], s[5 * 33], s[6 * 33], s[7 * 33]);
        o.z = pk4_fp8(s[8 * 33], s[9 * 33], s[10 * 33], s[11 * 33]); o.w = pk4_fp8(s[12 * 33], s[13 * 33], s[14 * 33], s[15 * 33]);
        *(u32x4*)(WT + (size_t)(drow0 + n) * Kd + k0 + 16 * c) = o; }
    asm volatile("s_waitcnt lgkmcnt(0)" ::: "memory");
}
__device__ __forceinline__ void moe_convert(const Frame& F, int l, int first, int stride) {
    LAS float* T = (LAS float*)F.lds;
    const int tid = F.tid;
    constexpr int NIT = NE * 3 * 32;
    f32x4 v[16];
#define MC_LOAD(it0) do { const int _it = l * NIT + (it0); const int _le = _it / 96, _q = _it % 96, _which = _q / 32, _kb = (_q % 32) >> 2, _nb = _q & 3; \
        const float* _W = inptr(F, _which == 0 ? 22 : (_which == 1 ? 23 : 24)) + (size_t)_le * D * D + (size_t)(128 * _kb) * D + 256 * _nb; \
        _Pragma("unroll") for (int i = 0; i < 16; ++i) { const int idx = tid + 512 * i, kk = idx >> 6, c4 = idx & 63; v[i] = *(const f32x4*)(_W + (size_t)kk * D + 4 * c4); } } while (0)
    if (first < NIT) MC_LOAD(first);
    for (int it0 = first; it0 < NIT; it0 += stride) {
        const int it = l * NIT + it0;
        const int le = it / 96, q = it % 96, which = q / 32, kb = (q % 32) >> 2, nb = q & 3, k0 = 128 * kb, n0 = 256 * nb;
#pragma unroll
        for (int i = 0; i < 16; ++i) { const int idx = tid + 512 * i, kk = idx >> 6, c4 = idx & 63; *(LAS f32x4*)(T + kk * 260 + 4 * c4) = v[i] * 64.0f; }
        if (it0 + stride < NIT) MC_LOAD(it0 + stride);
        __syncthreads();
        fp8* WT = (which == 2) ? F_WD + (size_t)le * D * D : F_WGU + (size_t)le * 2048 * D;
#pragma unroll
        for (int i = 0; i < 4; ++i) { const int idx = tid + 512 * i, n = idx & 255, c = idx >> 8;
            const LAS float* s = T + (16 * c) * 260 + n;
            u32x4 o; o.x = pk4_fp8(s[0 * 260], s[1 * 260], s[2 * 260], s[3 * 260]); o.y = pk4_fp8(s[4 * 260], s[5 * 260], s[6 * 260], s[7 * 260]);
            o.z = pk4_fp8(s[8 * 260], s[9 * 260], s[10 * 260], s[11 * 260]); o.w = pk4_fp8(s[12 * 260], s[13 * 260], s[14 * 260], s[15 * 260]);
            const int nn = n0 + n; const int drow = (which == 2) ? nn : ((nn >> 7) * 256 + (which == 1 ? 128 : 0) + (nn & 127));
            *(u32x4*)(WT + (size_t)drow * D + k0 + 16 * c) = o; }
        __syncthreads();
    }
#undef MC_LOAD
}
__device__ __forceinline__ void phase_prologue(const Frame& F) {
    const int gw = F.bid * 8 + F.wave, NGW = F.G * 8, lane = F.lane;
    auto part_a = [&]() {
        LAS float* scr = (LAS float*)(F.lds + F.wave * 16384);
        constexpr int I_IN = 16 * 89, I_OUT = 512, I_E = 512;
        constexpr int N_IN = DEPTH * I_IN, N_OUT = DEPTH * I_OUT, N_MOE = DEPTH * NE * 3 * I_E;
        for (int it = gw; it < N_IN + N_OUT; it += NGW) {
            int r = it;
            if (r < N_IN) { const int l = r / I_IN, q = r % I_IN, kb = q / 89, nb = q % 89;
                transpose_item_fp8(inptr(F, 8) + (size_t)l * D * NIN, NIN, 64 * kb, 32 * nb, F_WIN + (size_t)l * NPX * D, D, 32 * nb, scr, lane); continue; }
            r -= N_IN;
            if (r < N_OUT) { const int l = r / I_OUT, q = r % I_OUT, kb = q / 32, nb = q % 32;
                transpose_item_fp8(inptr(F, 19) + (size_t)l * D * D, D, 64 * kb, 32 * nb, F_WOUT + (size_t)l * D * D, D, 32 * nb, scr, lane); continue; }
        }
        for (int i = F.bid * 512 + F.tid; i < DEPTH * (NPX - NIN) * (D / 16); i += F.G * 512) { const int l = i / ((NPX - NIN) * (D / 16)), q = i % ((NPX - NIN) * (D / 16));
            *(u32x4*)(F_WIN + (size_t)l * NPX * D + (size_t)NIN * D + (size_t)q * 16) = (u32x4){0u, 0u, 0u, 0u}; }
        __syncthreads();
    };
    auto part_c = [&]() {
    if (F.bid == 0) { for (int i = F.tid; i < 64 * 12; i += 512) { const int p = i / 12, j = i % 12; const float inv = powf(10000.0f, -(float)(2 * j) / 24.0f); float sn, cs; sincosf((float)p * inv, &sn, &cs); F_ROPE[2 * i] = cs; F_ROPE[2 * i + 1] = sn; } }
    {
        LAS float* sL = (LAS float*)F.lds;
        LAS float* red = (LAS float*)(F.lds + 17 * 1024 * 4);
        for (int i = F.tid; i < 17 * 1024; i += 512) { const int r = i >> 10, k = i & 1023; const float v = r < 16 ? inptr(F, 1)[r * 1024 + k] : inptr(F, 3)[k]; sL[i] = v / (1.0f + expf(-v)); }
        __syncthreads();
        for (int u = F.bid; u < DEPTH * 96; u += F.G) {
            const int l = u / 96, n0 = (u % 96) * 64;
            const float* W = inptr(F, 4) + (size_t)l * D * 6144 + n0 + lane;
            float acc[17];
#pragma unroll
            for (int r = 0; r < 17; ++r) acc[r] = 0.f;
            const int kb = F.wave * 128;
            for (int k0 = 0; k0 < 128; k0 += 32) { float wv[32];
#pragma unroll
                for (int k = 0; k < 32; ++k) wv[k] = W[(size_t)(kb + k0 + k) * 6144];
#pragma unroll
                for (int k = 0; k < 32; ++k)
#pragma unroll
                    for (int r = 0; r < 17; ++r) acc[r] += sL[r * 1024 + kb + k0 + k] * wv[k]; }
#pragma unroll
            for (int r = 0; r < 17; ++r) red[(F.wave * 17 + r) * 64 + lane] = acc[r];
            __syncthreads();
            for (int i = F.tid; i < 17 * 64; i += 512) { const int r = i >> 6, nn = i & 63; float s = inptr(F, 5)[l * 6144 + n0 + nn];
#pragma unroll
                for (int w = 0; w < 8; ++w) s += red[(w * 17 + r) * 64 + nn];
                F_MOD[((size_t)l * 17 + r) * 6144 + n0 + nn] = s; }
            __syncthreads();
        }
    }
    };
    if (F.bid & 1) { part_a(); part_c(); } else { part_c(); part_a(); }
}

__device__ __forceinline__ void moe_tilebase_to_lds(const Frame& F, int lm) {
    LAS int* tab = (LAS int*)(F.lds + LDS_MOE);
    if (F.tid < 16) tab[F.tid] = (int)__hip_atomic_load(F_CTL + CW_MOE + (lm * 16 + F.tid) * 64, __ATOMIC_RELAXED, __HIP_MEMORY_SCOPE_AGENT);
    __syncthreads();
    if (F.tid == 0) { int acc = 0;
#pragma unroll
        for (int e = 0; e < 16; ++e) { tab[16 + e] = acc; acc += (tab[e] + 255) >> 8; } }
    __syncthreads();
}
__device__ __forceinline__ int moe_slot_row(const Frame& F, int slot) { const int v = F_SPOS[slot]; return ((const LAS int*)(F.lds + LDS_MOE))[16 + (v >> 20)] * 256 + (v & 0xFFFFF); }
template <bool DRY = false>
__device__ __forceinline__ void phase_norm1(const Frame& F, int l) {
    const int gw = F.bid * 8 + F.wave, NGW = F.G * 8, lane = F.lane;
    const int per = (MT + NGW - 1) / NGW, mstart = gw * per, mend = (mstart + per < MT) ? mstart + per : MT;
    const float* gmix = inptr(F, 6) + l * 1024;
    f32x4 gm[4];
#pragma unroll
    for (int j = 0; j < 4; ++j) gm[j] = *(const f32x4*)(gmix + 4 * lane + 256 * j);
    f32x4 ga[4], shv[4], g5v[4];
    struct Row { f32x4 xf[4]; u32x2 xb[4]; unsigned y0[4], y1[4]; float w0, w1; };
    Row R0, R1, R2, R3;
#define N1_LOAD(R, m) do { const bool _lat = (m) < ML; \
        if (l == 0) { const float* _xin = _lat ? inptr(F, 0) + (size_t)(m) * D : inptr(F, 2) + (size_t)((m) - ML) * D; _Pragma("unroll") for (int j = 0; j < 4; ++j) R.xf[j] = *(const f32x4*)(_xin + 4 * lane + 256 * j); } \
        else { const bf16* _x = F_XB + (size_t)(m) * D; const int _i = (m) - mstart; const fp8* _y0 = F_YBUF + (size_t)__builtin_amdgcn_readlane(rowA, _i) * D; const fp8* _y1 = F_YBUF + (size_t)__builtin_amdgcn_readlane(rowB, _i) * D; \
            R.w0 = __int_as_float(__builtin_amdgcn_readlane(__float_as_int(wA), _i)); R.w1 = __int_as_float(__builtin_amdgcn_readlane(__float_as_int(wB), _i)); \
            _Pragma("unroll") for (int j = 0; j < 4; ++j) { R.xb[j] = *(const u32x2*)(_x + 4 * lane + 256 * j); R.y0[j] = *(const unsigned*)(_y0 + 4 * lane + 256 * j); R.y1[j] = *(const unsigned*)(_y1 + 4 * lane + 256 * j); } } asm volatile("" ::: "memory"); } while (0)
#define N1_DO(R, m) do { \
        f32x4 v[4]; \
        if (l == 0) { _Pragma("unroll") for (int j = 0; j < 4; ++j) v[j] = R.xf[j]; } \
        else { bf16* _xst = F_XB + (size_t)(m) * D; \
            _Pragma("unroll") for (int j = 0; j < 4; ++j) { v[j] = bf4(R.xb[j]) + g5v[j] * (fp84(R.y0[j]) * R.w0 + fp84(R.y1[j]) * R.w1); \
                if (!DRY) { u32x2 _xw; _xw.x = cvt_pk_bf16(v[j][0], v[j][1]); _xw.y = cvt_pk_bf16(v[j][2], v[j][3]); *(u32x2*)(_xst + 4 * lane + 256 * j) = _xw; } } } \
        f32x2 _s2 = {0.f, 0.f};     \
        _Pragma("unroll") for (int j = 0; j < 4; ++j) { _s2 += v[j].xy * v[j].xy; _s2 += v[j].zw * v[j].zw; } \
        int _ri = __builtin_amdgcn_readfirstlane(__float_as_int(__builtin_amdgcn_rsqf(wave_sum(_s2[0] + _s2[1], lane) * (1.0f / D) + EPS))); asm volatile("" : "+s"(_ri)); const float _rstd = __int_as_float(_ri);     \
        fp8* _o = F_HX8 + (size_t)(m) * D; \
        _Pragma("unroll") for (int j = 0; j < 4; ++j) { const f32x4 _h = v[j] * _rstd * ga[j] + shv[j]; *(unsigned*)(_o + 4 * lane + 256 * j) = pk4_fp8(_h[0], _h[1], _h[2], _h[3]); } } while (0)
    int rowA = 0, rowB = 0; float wA = 0.f, wB = 0.f;
    if (l > 0) { moe_tilebase_to_lds(F, l - 1);
        const int mi = mstart + lane; if (lane < per && mi < mend) { rowA = moe_slot_row(F, 2 * mi); rowB = moe_slot_row(F, 2 * mi + 1); wA = F_SLOTW[2 * mi] * 0.0625f; wB = F_SLOTW[2 * mi + 1] * 0.0625f; } }
    for (int m0 = mstart; m0 < mend; ) {
        const int b = m0 < ML ? (m0 >> 11) : 16; const int e0 = (b < 16) ? ((b + 1) << 11) : mend; const int e = e0 < mend ? e0 : mend, el = e - 1;
        { const float* _mp = F_MOD + ((size_t)l * 17 + b) * 6144; const float* _g5 = F_MOD + ((size_t)(l > 0 ? l - 1 : 0) * 17 + b) * 6144 + 5 * 1024;
#pragma unroll
          for (int j = 0; j < 4; ++j) { shv[j] = *(const f32x4*)(_mp + 4 * lane + 256 * j); ga[j] = gm[j] * (*(const f32x4*)(_mp + 1024 + 4 * lane + 256 * j) + 1.0f); g5v[j] = *(const f32x4*)(_g5 + 4 * lane + 256 * j); } }
#define N1_CL(x) ((x) < el ? (x) : el)
        N1_LOAD(R0, m0); N1_LOAD(R1, N1_CL(m0 + 1)); N1_LOAD(R2, N1_CL(m0 + 2));
        for (int m = m0; m < e; m += 4) {
            N1_LOAD(R3, N1_CL(m + 3)); N1_DO(R0, m);
            N1_LOAD(R0, N1_CL(m + 4)); if (m + 1 < e) N1_DO(R1, m + 1);
            N1_LOAD(R1, N1_CL(m + 5)); if (m + 2 < e) N1_DO(R2, m + 2);
            N1_LOAD(R2, N1_CL(m + 6)); if (m + 3 < e) N1_DO(R3, m + 3);
        }
#undef N1_CL
        m0 = e;
    }
#undef N1_LOAD
#undef N1_DO
}

__device__ __forceinline__ void router_fold(const Frame& F, int l) {
    const float* rw = inptr(F, 20); const float* gffn = inptr(F, 7) + l * 1024; const float* modl = F_MOD + (size_t)l * 17 * 6144;
    for (int idx = F.bid * 512 + F.tid; idx < 17 * 32 * 64; idx += F.G * 512) { const int b = idx >> 11, s = (idx >> 6) & 31, ln = idx & 63, g = ln >> 4, e = ln & 15;
        float hi[8], lo[8];
#pragma unroll
        for (int j = 0; j < 8; ++j) { const int k = 32 * s + 8 * g + j; const float v = gffn[k] * (1.0f + modl[b * 6144 + 4 * 1024 + k]) * rw[k * 16 + e];
            const float h = __uint_as_float(cvt_pk_bf16(v, 0.f) << 16); hi[j] = h; lo[j] = v - h; }
        u32x4 wh, wl; wh.x = cvt_pk_bf16(hi[0], hi[1]); wh.y = cvt_pk_bf16(hi[2], hi[3]); wh.z = cvt_pk_bf16(hi[4], hi[5]); wh.w = cvt_pk_bf16(hi[6], hi[7]);
        wl.x = cvt_pk_bf16(lo[0], lo[1]); wl.y = cvt_pk_bf16(lo[2], lo[3]); wl.z = cvt_pk_bf16(lo[4], lo[5]); wl.w = cvt_pk_bf16(lo[6], lo[7]);
        *(u32x4*)(F_RWH + (size_t)idx * 8) = wh; *(u32x4*)(F_RWL + (size_t)idx * 8) = wl; }
    for (int idx = F.bid * 512 + F.tid; idx < 17 * 1024; idx += F.G * 512) { const int b = idx >> 10, k = idx & 1023;
        F_AF[idx] = gffn[k] * (1.0f + modl[b * 6144 + 4 * 1024 + k]); F_BF[idx] = modl[b * 6144 + 3 * 1024 + k]; }
    const int gw = F.bid * 8 + F.wave, NGW = F.G * 8, lane = F.lane;
    for (int o = gw; o < 17 * 16; o += NGW) { const int b = o >> 4, e = o & 15; float acc = 0.f;
#pragma unroll
        for (int j = 0; j < 16; ++j) { const int k = lane + 64 * j; acc += modl[b * 6144 + 3 * 1024 + k] * rw[k * 16 + e]; }
        acc = wave_sum(acc, lane); if (lane == 0) F_CB[o] = acc; }
}
__device__ __forceinline__ void route_select(const float (&lgt)[16], const float (&rb)[16], int& be0, int& be1, float& w0, float& w1) {
    float aff[16], sel[16];
#pragma unroll
    for (int e = 0; e < 16; ++e) { aff[e] = 1.0f / (1.0f + expf(-lgt[e])); sel[e] = aff[e] + rb[e]; }
    float bs = -3.0e38f, ba0 = 0.f, ba1 = 0.f; be0 = 0; be1 = 1;
#pragma unroll
    for (int gg = 0; gg < 4; ++gg) {
        float m1 = sel[4 * gg], a1 = aff[4 * gg]; int i1 = 4 * gg;
#pragma unroll
        for (int k = 1; k < 4; ++k) if (sel[4 * gg + k] > m1) { m1 = sel[4 * gg + k]; a1 = aff[4 * gg + k]; i1 = 4 * gg + k; }
        float m2 = -3.0e38f, a2 = 0.f; int i2 = 0;
#pragma unroll
        for (int k = 0; k < 4; ++k) if ((4 * gg + k) != i1 && sel[4 * gg + k] > m2) { m2 = sel[4 * gg + k]; a2 = aff[4 * gg + k]; i2 = 4 * gg + k; }
        const float gs = m1 + m2;
        if (gs > bs) { bs = gs; be0 = i1; be1 = i2; ba0 = a1; ba1 = a2; }
    }
    const float inv = 1.0f / (ba0 + ba1); w0 = ba0 * inv; w1 = ba1 * inv;
}
__device__ __forceinline__ void phase_norm2_router(const Frame& F, int l) {
    int tid_ = F.tid; asm volatile("" : "+v"(tid_));
    const int tid = tid_, lane = tid & 63, wave = F.wave;
    const int Mrows = (l == DEPTH - 1) ? ML : MT, NT16 = Mrows / 16;
    LAS unsigned char* RWHl = F.lds; LAS unsigned char* RWLl = F.lds + 32768;
    LAS f32x4* abL = (LAS f32x4*)(F.lds + 65536);
    LAS float* lgL = (LAS float*)(F.lds + 73728) + wave * 256;
    LAS float* ssp = (LAS float*)(F.lds + 81920);
    LAS float* lgp = ssp + 128;
    float rb[16];
#pragma unroll
    for (int e = 0; e < 16; ++e) rb[e] = inptr(F, 21)[e];
    int my_e0 = 0, my_e1 = 0, my_m = -1; float my_w0 = 0.f, my_w1 = 0.f;
#define N2_STAGE(b) do { \
        _Pragma("unroll") for (int i = 0; i < 4; ++i) { const int idx = tid + 512 * i; *(LAS u32x4*)(RWHl + idx * 16) = *(const u32x4*)(F_RWH + ((size_t)(b) * 2048 + idx) * 8); *(LAS u32x4*)(RWLl + idx * 16) = *(const u32x4*)(F_RWL + ((size_t)(b) * 2048 + idx) * 8); } \
        abL[tid] = *((const f32x4*)((tid < 256 ? F_AF : F_BF) + (b) * 1024) + (tid & 255)); } while (0)
    const int t1 = F.bid * 8 + wave;
    if (F.bid * 8 < NT16) {
        const int b = (128 * F.bid < ML) ? ((128 * F.bid) >> 11) : 16;
        N2_STAGE(b);
        __syncthreads();
        if (t1 < NT16) {
            int g_ = lane >> 4, r_ = lane & 15; asm volatile("" : "+v"(g_), "+v"(r_) :: "memory");
            const int g = g_, r = r_;
            const int m = 16 * t1 + r;
            const bf16* xrow = F_XB + (size_t)m * D + 8 * g;
            u32x4 xr[32];
#pragma unroll
            for (int s = 0; s < 32; ++s) xr[s] = *(const u32x4*)(xrow + 32 * s);
            float ss = 0.f;
#pragma unroll
            for (int s = 0; s < 32; ++s) { const u32x4 w = xr[s];
                const float a0 = bflo(w.x), a1 = bfhi(w.x), a2 = bflo(w.y), a3 = bfhi(w.y), a4 = bflo(w.z), a5 = bfhi(w.z), a6 = bflo(w.w), a7 = bfhi(w.w);
                ss += ((a0 * a0 + a1 * a1) + (a2 * a2 + a3 * a3)) + ((a4 * a4 + a5 * a5) + (a6 * a6 + a7 * a7)); }
            ss += shx(ss, 16, lane); ss += shx(ss, 32, lane);
            const float rstd = 1.0f / sqrtf(ss * (1.0f / D) + EPS);
            f32x4 acc = (f32x4){0.f, 0.f, 0.f, 0.f};
#pragma unroll
            for (int s = 0; s < 32; ++s) { const bf16x8 bh = *(const LAS bf16x8*)(RWHl + (s * 64 + lane) * 16), bl = *(const LAS bf16x8*)(RWLl + (s * 64 + lane) * 16); const bf16x8 xa = __builtin_bit_cast(bf16x8, xr[s]);
                acc = __builtin_amdgcn_mfma_f32_16x16x32_bf16(xa, bh, acc, 0, 0, 0); acc = __builtin_amdgcn_mfma_f32_16x16x32_bf16(xa, bl, acc, 0, 0, 0); }
            fp8* orow = F_HX8 + (size_t)m * D + 8 * g;
#pragma unroll
            for (int s = 0; s < 32; ++s) { const int k4 = 8 * s + 2 * g; u32x4 w = xr[s]; asm volatile("" : "+v"(w));
                const f32x4 a0 = abL[k4], a1 = abL[k4 + 1], h0 = abL[256 + k4], h1 = abL[256 + k4 + 1];
                const f32x4 x0 = (f32x4){bflo(w.x), bfhi(w.x), bflo(w.y), bfhi(w.y)}, x1 = (f32x4){bflo(w.z), bfhi(w.z), bflo(w.w), bfhi(w.w)};
                const f32x4 y0 = x0 * rstd * a0 + h0, y1 = x1 * rstd * a1 + h1;
                u32x2 o; o.x = pk4_fp8(y0[0], y0[1], y0[2], y0[3]); o.y = pk4_fp8(y1[0], y1[1], y1[2], y1[3]); *(u32x2*)(orow + 32 * s) = o; }
            const float cbv = F_CB[b * 16 + r];
#pragma unroll
            for (int j = 0; j < 4; ++j) { const float rs = __int_as_float(__builtin_amdgcn_ds_bpermute((4 * g + j) << 2, __float_as_int(rstd)));
                lgL[(4 * g + j) * 16 + r] = acc[j] * rs + cbv; }
            asm volatile("s_waitcnt lgkmcnt(0)" ::: "memory");
            float lgt[16];
#pragma unroll
            for (int q4 = 0; q4 < 4; ++q4) { const f32x4 v = *(const LAS f32x4*)(lgL + r * 16 + 4 * q4); lgt[4 * q4] = v[0]; lgt[4 * q4 + 1] = v[1]; lgt[4 * q4 + 2] = v[2]; lgt[4 * q4 + 3] = v[3]; }
            int be0, be1; float w0, w1; route_select(lgt, rb, be0, be1, w0, w1);
            if ((lane >> 4) == 0) { my_e0 = be0; my_e1 = be1; my_w0 = w0; my_w1 = w1; my_m = m; }
        }
    }
    int ord = 1;
    for (int t2 = 8 * F.G + F.bid; t2 < NT16; t2 += F.G, ++ord) {
        const int m0 = 16 * t2, b = (m0 < ML) ? (m0 >> 11) : 16;
        __syncthreads();
        N2_STAGE(b);
        __syncthreads();
        int g_ = lane >> 4, r_ = lane & 15; asm volatile("" : "+v"(g_), "+v"(r_) :: "memory");
        const int g = g_, r = r_;
        const int m = m0 + r;
        const bf16* xrow = F_XB + (size_t)m * D + 8 * g + 128 * wave;
        u32x4 xq[4];
#pragma unroll
        for (int s = 0; s < 4; ++s) xq[s] = *(const u32x4*)(xrow + 32 * s);
        float ss = 0.f; f32x4 acc = (f32x4){0.f, 0.f, 0.f, 0.f};
#pragma unroll
        for (int s = 0; s < 4; ++s) { const u32x4 w = xq[s]; const int sg = 4 * wave + s;
            const float a0 = bflo(w.x), a1 = bfhi(w.x), a2 = bflo(w.y), a3 = bfhi(w.y), a4 = bflo(w.z), a5 = bfhi(w.z), a6 = bflo(w.w), a7 = bfhi(w.w);
            ss += ((a0 * a0 + a1 * a1) + (a2 * a2 + a3 * a3)) + ((a4 * a4 + a5 * a5) + (a6 * a6 + a7 * a7));
            const bf16x8 bh = *(const LAS bf16x8*)(RWHl + (sg * 64 + lane) * 16), bl = *(const LAS bf16x8*)(RWLl + (sg * 64 + lane) * 16); const bf16x8 xa = __builtin_bit_cast(bf16x8, w);
            acc = __builtin_amdgcn_mfma_f32_16x16x32_bf16(xa, bh, acc, 0, 0, 0); acc = __builtin_amdgcn_mfma_f32_16x16x32_bf16(xa, bl, acc, 0, 0, 0); }
        ss += shx(ss, 16, lane); ss += shx(ss, 32, lane);
        if (g == 0) ssp[wave * 16 + r] = ss;
#pragma unroll
        for (int j = 0; j < 4; ++j) lgp[wave * 256 + (4 * g + j) * 16 + r] = acc[j];
        __syncthreads();
        float tot = 0.f;
#pragma unroll
        for (int w = 0; w < 8; ++w) tot += ssp[w * 16 + r];
        const float rstd = 1.0f / sqrtf(tot * (1.0f / D) + EPS);
        fp8* orow = F_HX8 + (size_t)m * D + 8 * g + 128 * wave;
#pragma unroll
        for (int s = 0; s < 4; ++s) { const int k4 = 8 * (4 * wave + s) + 2 * g; const u32x4 w = xq[s];
            const f32x4 a0 = abL[k4], a1 = abL[k4 + 1], h0 = abL[256 + k4], h1 = abL[256 + k4 + 1];
            const f32x4 x0 = (f32x4){bflo(w.x), bfhi(w.x), bflo(w.y), bfhi(w.y)}, x1 = (f32x4){bflo(w.z), bfhi(w.z), bflo(w.w), bfhi(w.w)};
            const f32x4 y0 = x0 * rstd * a0 + h0, y1 = x1 * rstd * a1 + h1;
            u32x2 o; o.x = pk4_fp8(y0[0], y0[1], y0[2], y0[3]); o.y = pk4_fp8(y1[0], y1[1], y1[2], y1[3]); *(u32x2*)(orow + 32 * s) = o; }
        if (wave == 0) {
            float lgt[16];
#pragma unroll
            for (int q4 = 0; q4 < 4; ++q4) { f32x4 v = (f32x4){0.f, 0.f, 0.f, 0.f};
#pragma unroll
                for (int w = 0; w < 8; ++w) v += *(const LAS f32x4*)(lgp + w * 256 + r * 16 + 4 * q4);
                const f32x4 cb4 = *(const f32x4*)(F_CB + b * 16 + 4 * q4);
                lgt[4 * q4] = v[0] * rstd + cb4[0]; lgt[4 * q4 + 1] = v[1] * rstd + cb4[1]; lgt[4 * q4 + 2] = v[2] * rstd + cb4[2]; lgt[4 * q4 + 3] = v[3] * rstd + cb4[3]; }
            int be0, be1; float w0, w1; route_select(lgt, rb, be0, be1, w0, w1);
            if ((lane >> 4) == ord) { my_e0 = be0; my_e1 = be1; my_w0 = w0; my_w1 = w1; my_m = m; }
        }
    }
#undef N2_STAGE
    __syncthreads();
    {
        LAS int* cntw = (LAS int*)(F.lds + 98304);
        LAS int* baseL = cntw + 128;
        const bool valid = my_m >= 0; const unsigned long long lt = (1ull << lane) - 1ull;
        int r0 = 0, r1 = 0, mycnt = 0;
#pragma unroll
        for (int e = 0; e < 16; ++e) {
            const unsigned long long m0 = __ballot(valid && my_e0 == e), m1 = __ballot(valid && my_e1 == e);
            if (my_e0 == e) r0 = __popcll(m0 & lt);
            if (my_e1 == e) r1 = __popcll(m0) + __popcll(m1 & lt);
            if (lane == e) mycnt = __popcll(m0) + __popcll(m1);
        }
        if (lane < 16) cntw[wave * 16 + lane] = mycnt;
        __syncthreads();
        if (tid < 16) { int tot = 0;
#pragma unroll
            for (int w = 0; w < 8; ++w) { const int c = cntw[w * 16 + tid]; cntw[w * 16 + tid] = tot; tot += c; }
            baseL[tid] = (int)atomicAdd(F_CTL + CW_MOE + (l * 16 + tid) * 64, (unsigned)tot); }
        __syncthreads();
        if (valid) {
            F_SLOTW[2 * my_m] = my_w0; F_SLOTW[2 * my_m + 1] = my_w1;
            const int p0 = baseL[my_e0] + cntw[wave * 16 + my_e0] + r0, p1 = baseL[my_e1] + cntw[wave * 16 + my_e1] + r1;
            F_LIST[(size_t)my_e0 * MT + p0] = 2 * my_m; F_LIST[(size_t)my_e1 * MT + p1] = 2 * my_m + 1;
            F_SPOS[2 * my_m] = (my_e0 << 20) | p0; F_SPOS[2 * my_m + 1] = (my_e1 << 20) | p1;
        }
    }
    __syncthreads();
}

__device__ __forceinline__ void moe_setup(const Frame& F, int l, MoeOrder& S, int NT) {
    LAS int* tab = (LAS int*)(F.lds + LDS_MOE);
    LAS int* rows = (LAS int*)(F.lds + LDS_ROWS);
    if (F.tid < 16) tab[F.tid] = (int)__hip_atomic_load(F_CTL + CW_MOE + (l * 16 + F.tid) * 64, __ATOMIC_RELAXED, __HIP_MEMORY_SCOPE_AGENT);
    __syncthreads();
    if (F.tid == 0) { int acc = 0;
#pragma unroll
        for (int e = 0; e < 16; ++e) { tab[16 + e] = acc; acc += (tab[e] + 255) >> 8; }
        tab[32] = acc; }
    __syncthreads();
    S.mbase = tab + 16; S.rows = rows; S.NT = NT; S.G = F.G; S.c = F.bid; S.TM = __builtin_amdgcn_readfirstlane(tab[32]); S.rowbytes = 1024u;
    if (NT == 8 && F.tid < 256) {
        int val[MAXU]; bool keep[MAXU];
#pragma unroll
        for (int i = 0; i < MAXU; ++i) { pg8::Unit u; const bool ok = S.next(i, u);
            const int e = ok ? u.pn / NT : 0, jt = ok ? u.pm - tab[16 + e] : 0, r = jt * 256 + F.tid; const bool in = ok && (r < tab[e]);
            val[i] = F_LIST[(size_t)e * MT + (in ? r : 0)]; keep[i] = in; }
#pragma unroll
        for (int i = 0; i < MAXU; ++i) rows[i * 256 + F.tid] = keep[i] ? val[i] : -1;
    }
    __syncthreads();
}

__device__ __forceinline__ void na_unit(const Frame& F, int l, int kind, int b, int h, int idx) {
    LAS unsigned char* Kl = F.lds;
    LAS float* rpbL = (LAS float*)(F.lds + 110592);
    LAS float* mrg = (LAS float*)(F.lds + 112640);
    const int tid = F.tid, lane = F.lane, w = F.wave, g = lane >> 4, c = lane & 15, qb = w & 3, part = w >> 2;
    const int r = idx, r0 = (r - 4 < 0) ? 0 : ((r - 4 > 24) ? 24 : r - 4);
    const bf16* px = F_PX;
#define NA_STAGE(COL) do { \
        if (kind == 0) { \
            _Pragma("unroll") for (int k = 0; k < 8; ++k) { const int ch = tid + 512 * k, key = ch >> 3, p = ch & 7; \
                *(LAS u32x4*)(Kl + key * 144 + p * 16) = *(const u32x4*)(((COL) == C_NK ? F_KNL : F_VNL) + ((size_t)(b * 6 + h) * 2048 + r0 * 64) * 64 + ch * 8); } \
            _Pragma("unroll") for (int k = 0; k < 4; ++k) { const int ch = tid + 512 * k, key = ch >> 3, p = ch & 7; \
                *(LAS u32x4*)(Kl + (512 + key) * 144 + p * 16) = *(const u32x4*)(((COL) == C_NK ? F_KNC : F_VNC) + (size_t)(b * 6 + h) * 256 * 64 + ch * 8); } \
        } else { \
            _Pragma("unroll") for (int k = 0; k < 6; ++k) { const int ch = tid + 512 * k, row = ch >> 3, p = ch & 7; \
                *(LAS u32x4*)(Kl + row * 144 + p * 16) = *(const u32x4*)(((COL) == C_NK ? F_KNC : F_VNC) + ((size_t)(b * 6 + h) * 256 + (row & 255)) * 64 + p * 8); } \
        } } while (0)
    NA_STAGE(C_NK);
    if (kind == 0) { const float* rp = inptr(F, 14) + ((size_t)l * 6 + h) * 465; for (int i = tid; i < 465; i += 512) rpbL[i] = rp[i]; }
    const int mq = (kind == 0) ? (b * 2048 + r * 64 + 16 * qb + c) : (ML + b * 256 + idx * 64 + 16 * qb + c);
    const bf16x8 q0 = *(const bf16x8*)(px + (size_t)mq * NPX + C_NQ + h * 64 + 8 * g), q1 = *(const bf16x8*)(px + (size_t)mq * NPX + C_NQ + h * 64 + 32 + 8 * g);
    __syncthreads();
    const int cs = (kind == 0) ? (qb == 0 ? 0 : (qb == 1 ? 8 : (qb == 2 ? 24 : 32))) : 0;
    const int kbase = (kind == 0) ? (part == 0 ? cs : 512) : part * 128;
    const int st2 = ((kind == 0 && part == 0) ? 64 : 32) * 144;
    const int abase = (kbase + c) * 144 + 16 * g;
    f32x4 s[16];
#pragma unroll
    for (int t = 0; t < 16; ++t) {
        const LAS unsigned char* kp = Kl + abase + (t >> 1) * st2 + (t & 1) * 2304;
        const bf16x8 a0 = *(const LAS bf16x8*)(kp), a1 = *(const LAS bf16x8*)(kp + 64);
        f32x4 z = (f32x4){0.f, 0.f, 0.f, 0.f};
        z = __builtin_amdgcn_mfma_f32_16x16x32_bf16(a0, q0, z, 0, 0, 0);
        z = __builtin_amdgcn_mfma_f32_16x16x32_bf16(a1, q1, z, 0, 0, 0);
        s[t] = z;
    }
    const float NEG = -__builtin_inff();
    if (kind == 0 && part == 0) {
        const int cq = 16 * qb + c, c0 = (cq - 8 < 0) ? 0 : ((cq - 8 > 48) ? 48 : cq - 8);
#pragma unroll
        for (int t = 0; t < 16; ++t) { const int i = t >> 1, drow = r0 + i - r + 7;
#pragma unroll
            for (int j = 0; j < 4; ++j) { const int col = cs + 16 * (t & 1) + 4 * g + j; const bool valid = (col >= c0) && (col < c0 + 16);
                int dcol = col - cq + 15; dcol = dcol < 0 ? 0 : (dcol > 30 ? 30 : dcol);
                const float bias = rpbL[drow * 31 + dcol];
                s[t][j] = valid ? (s[t][j] * 0.125f + bias) : NEG; } }
    } else if (kind == 0) {
#pragma unroll
        for (int t = 0; t < 16; ++t) s[t] = s[t] * 0.125f;
    } else {
#pragma unroll
        for (int t = 0; t < 16; ++t) {
#pragma unroll
            for (int j = 0; j < 4; ++j) s[t][j] = (t < 8) ? s[t][j] * 0.125f : NEG; }
    }
    float mx = NEG;
#pragma unroll
    for (int t = 0; t < 16; ++t)
#pragma unroll
        for (int j = 0; j < 4; ++j) mx = fmaxf(mx, s[t][j]);
    mx = fmaxf(mx, shx(mx, 16, lane)); mx = fmaxf(mx, shx(mx, 32, lane));
    float lsum = 0.f;
#pragma unroll
    for (int t = 0; t < 16; ++t)
#pragma unroll
        for (int j = 0; j < 4; ++j) { const float p = __expf(s[t][j] - mx); s[t][j] = p; lsum += p; }
    lsum += shx(lsum, 16, lane); lsum += shx(lsum, 32, lane);
    __syncthreads();
    NA_STAGE(C_NV);
    __syncthreads();
    f32x4 o[4];
#pragma unroll
    for (int nt = 0; nt < 4; ++nt) o[nt] = (f32x4){0.f, 0.f, 0.f, 0.f};
    const int vbase = (kbase + 4 * g + (c >> 2)) * 144 + 8 * (c & 3);
#pragma unroll
    for (int ks = 0; ks < 8; ++ks) {
        bf16x8 pb; { const unsigned w0 = cvt_pk_bf16(s[2 * ks][0], s[2 * ks][1]), w1 = cvt_pk_bf16(s[2 * ks][2], s[2 * ks][3]), w2 = cvt_pk_bf16(s[2 * ks + 1][0], s[2 * ks + 1][1]), w3 = cvt_pk_bf16(s[2 * ks + 1][2], s[2 * ks + 1][3]);
            u32x4 pw = (u32x4){w0, w1, w2, w3}; pb = __builtin_bit_cast(bf16x8, pw); }
        LAS unsigned char* vp = Kl + vbase + ks * st2;
#pragma unroll
        for (int nt = 0; nt < 4; ++nt) {
            const s16x4 t0 = __builtin_amdgcn_ds_read_tr16_b64_v4i16((LAS s16x4*)(vp + 32 * nt));
            const s16x4 t1 = __builtin_amdgcn_ds_read_tr16_b64_v4i16((LAS s16x4*)(vp + 2304 + 32 * nt));
            const bf16x8 va = (bf16x8){t0[0], t0[1], t0[2], t0[3], t1[0], t1[1], t1[2], t1[3]};
            o[nt] = __builtin_amdgcn_mfma_f32_16x16x32_bf16(va, pb, o[nt], 0, 0, 0);
        }
    }
    if (part == 1) { LAS float* mp = mrg + (qb * 64 + lane) * 18; mp[0] = mx; mp[1] = lsum;
#pragma unroll
        for (int nt = 0; nt < 4; ++nt)
#pragma unroll
            for (int j = 0; j < 4; ++j) mp[2 + 4 * nt + j] = o[nt][j]; }
    __syncthreads();
    if (part == 0) { const LAS float* mp = mrg + (qb * 64 + lane) * 18; const float m2 = mp[0], l2 = mp[1];
        const float M = fmaxf(mx, m2), f1 = __expf(mx - M), f2 = __expf(m2 - M), inv = 1.0f / (lsum * f1 + l2 * f2);
        fp8* op = F_MIX + (size_t)mq * D + 384 + h * 64 + 4 * g;
#pragma unroll
        for (int nt = 0; nt < 4; ++nt) { float r4[4];
#pragma unroll
            for (int j = 0; j < 4; ++j) r4[j] = (o[nt][j] * f1 + mp[2 + 4 * nt + j] * f2) * inv;
            *(unsigned*)(op + 16 * nt) = pk4_fp8(r4[0], r4[1], r4[2], r4[3]); } }
    __syncthreads();
#undef NA_STAGE
}

__device__ __forceinline__ void na_latent_phase(const Frame& F, int l) {
    LAS unsigned char* Kl = F.lds;
    LAS float* rpbL = (LAS float*)(F.lds + 110592);
    LAS float* mrg = (LAS float*)(F.lds + 112640);
    int tid_ = F.tid; asm volatile("" : "+v"(tid_));
    const int tid = tid_, lane = tid & 63, w = F.wave, g = lane >> 4, c = lane & 15, qb = w & 3, part = w >> 2;
    const bf16* px = F_PX;
    const int r = F.bid >> 3, r0 = (r - 4 < 0) ? 0 : ((r - 4 > 24) ? 24 : r - 4), bh0 = F.bid & 7;
    u32x4 kv[12]; bf16x8 qn0, qn1; float rpn = 0.f;
#define NA_LOAD(COL, ii) do { const int _bh = bh0 + 8 * (ii), _b = _bh / 6, _h = _bh % 6; \
        _Pragma("unroll") for (int k = 0; k < 8; ++k) { const int ch = tid + 512 * k; \
            kv[k] = *(const u32x4*)(((COL) == C_NK ? F_KNL : F_VNL) + ((size_t)(_b * 6 + _h) * 2048 + r0 * 64) * 64 + ch * 8); }        \
        _Pragma("unroll") for (int k = 0; k < 4; ++k) { const int ch = tid + 512 * k; \
            kv[8 + k] = *(const u32x4*)(((COL) == C_NK ? F_KNC : F_VNC) + (size_t)(_b * 6 + _h) * 256 * 64 + ch * 8); } } while (0)
#define NA_PUT() do { \
        _Pragma("unroll") for (int k = 0; k < 8; ++k) { const int ch = tid + 512 * k, key = ch >> 3, p = ch & 7; *(LAS u32x4*)(Kl + key * 144 + p * 16) = kv[k]; } \
        _Pragma("unroll") for (int k = 0; k < 4; ++k) { const int ch = tid + 512 * k, key = ch >> 3, p = ch & 7; *(LAS u32x4*)(Kl + (512 + key) * 144 + p * 16) = kv[8 + k]; } } while (0)
#define NA_LOADQ(ii) do { const int _bh = bh0 + 8 * (ii), _b = _bh / 6, _h = _bh % 6; const int _mq = _b * 2048 + r * 64 + 16 * qb + c; \
        qn0 = *(const bf16x8*)(px + (size_t)_mq * NPX + C_NQ + _h * 64 + 8 * g); qn1 = *(const bf16x8*)(px + (size_t)_mq * NPX + C_NQ + _h * 64 + 32 + 8 * g); \
        if (tid < 465) rpn = inptr(F, 14)[((size_t)l * 6 + _h) * 465 + tid]; } while (0)
    NA_LOAD(C_NK, 0); NA_LOADQ(0);
    const int cs = (qb == 0 ? 0 : (qb == 1 ? 8 : (qb == 2 ? 24 : 32)));
    const int kbase = (part == 0 ? cs : 512), st2 = (part == 0 ? 64 : 32) * 144;
    const int abase = (kbase + c) * 144 + 16 * g, vbase = (kbase + 4 * g + (c >> 2)) * 144 + 8 * (c & 3);
    const float NEG = -__builtin_inff();
    int bcol[8];
    { const int cq = 16 * qb + c, c0 = (cq - 8 < 0) ? 0 : ((cq - 8 > 48) ? 48 : cq - 8);
#pragma unroll
      for (int k = 0; k < 8; ++k) { const int col = cs + 16 * (k >> 2) + 4 * g + (k & 3); const bool valid = (col >= c0) && (col < c0 + 16);
          int dcol = col - cq + 15; dcol = dcol < 0 ? 0 : (dcol > 30 ? 30 : dcol); bcol[k] = valid ? dcol : 31; } }
    const int rpw = (tid < 465) ? (tid / 31) * 32 + tid % 31 : 0;
    for (int i = 0; i < 12; ++i) {
        const int bh = bh0 + 8 * i, b = bh / 6, h = bh % 6;
        NA_PUT();
        if (tid < 465) rpbL[rpw] = rpn * 1.4426950408889634f; else if (tid < 480) rpbL[(tid - 465) * 32 + 31] = NEG;
        const bf16x8 q0 = qn0, q1 = qn1;
        NA_LOAD(C_NV, i);
        __syncthreads();
        f32x4 s[16];
#pragma unroll
        for (int t = 0; t < 16; ++t) {
            const LAS unsigned char* kp = Kl + abase + (t >> 1) * st2 + (t & 1) * 2304;
            const bf16x8 a0 = *(const LAS bf16x8*)(kp), a1 = *(const LAS bf16x8*)(kp + 64);
            f32x4 z = (f32x4){0.f, 0.f, 0.f, 0.f};
            z = __builtin_amdgcn_mfma_f32_16x16x32_bf16(a0, q0, z, 0, 0, 0);
            z = __builtin_amdgcn_mfma_f32_16x16x32_bf16(a1, q1, z, 0, 0, 0);
            s[t] = z;
        }
        constexpr float L2E = 1.4426950408889634f;
        if (part == 0) {
#pragma unroll
            for (int t = 0; t < 16; ++t) { const LAS float* brow = rpbL + (r0 + (t >> 1) - r + 7) * 32; const int k0 = 4 * (t & 1);
                f32x4 bias; bias[0] = brow[bcol[k0]]; bias[1] = brow[bcol[k0 + 1]]; bias[2] = brow[bcol[k0 + 2]]; bias[3] = brow[bcol[k0 + 3]];
                s[t] = s[t] * (0.125f * L2E) + bias; }
        } else {
#pragma unroll
            for (int t = 0; t < 16; ++t) s[t] = s[t] * (0.125f * L2E);
        }
        float mx;
        { f32x4 m4 = s[0];
#pragma unroll
          for (int t = 1; t < 16; ++t) { m4[0] = fmaxf(m4[0], s[t][0]); m4[1] = fmaxf(m4[1], s[t][1]); m4[2] = fmaxf(m4[2], s[t][2]); m4[3] = fmaxf(m4[3], s[t][3]); }
          mx = fmaxf(fmaxf(m4[0], m4[1]), fmaxf(m4[2], m4[3])); }
        mx = fmaxf(mx, shx(mx, 16, lane)); mx = fmaxf(mx, shx(mx, 32, lane));
        float lsum;
        { f32x4 l4 = (f32x4){0.f, 0.f, 0.f, 0.f};
#pragma unroll
          for (int t = 0; t < 16; ++t) { const f32x4 d = s[t] - mx; f32x4 p; p[0] = __builtin_amdgcn_exp2f(d[0]); p[1] = __builtin_amdgcn_exp2f(d[1]); p[2] = __builtin_amdgcn_exp2f(d[2]); p[3] = __builtin_amdgcn_exp2f(d[3]); s[t] = p; l4 += p; }
          lsum = (l4[0] + l4[1]) + (l4[2] + l4[3]); }
        lsum += shx(lsum, 16, lane); lsum += shx(lsum, 32, lane);
        __syncthreads();
        NA_PUT();
        if (i + 1 < 12) { NA_LOAD(C_NK, i + 1); NA_LOADQ(i + 1); }
        __syncthreads();
        f32x4 o[4];
#pragma unroll
        for (int nt = 0; nt < 4; ++nt) o[nt] = (f32x4){0.f, 0.f, 0.f, 0.f};
#pragma unroll
        for (int ks = 0; ks < 8; ++ks) {
            bf16x8 pb; { u32x4 pw = (u32x4){cvt_pk_bf16(s[2 * ks][0], s[2 * ks][1]), cvt_pk_bf16(s[2 * ks][2], s[2 * ks][3]), cvt_pk_bf16(s[2 * ks + 1][0], s[2 * ks + 1][1]), cvt_pk_bf16(s[2 * ks + 1][2], s[2 * ks + 1][3])}; pb = __builtin_bit_cast(bf16x8, pw); }
            LAS unsigned char* vp = Kl + vbase + ks * st2;
#pragma unroll
            for (int nt = 0; nt < 4; ++nt) {
                const s16x4 t0 = __builtin_amdgcn_ds_read_tr16_b64_v4i16((LAS s16x4*)(vp + 32 * nt));
                const s16x4 t1 = __builtin_amdgcn_ds_read_tr16_b64_v4i16((LAS s16x4*)(vp + 2304 + 32 * nt));
                const bf16x8 va = (bf16x8){t0[0], t0[1], t0[2], t0[3], t1[0], t1[1], t1[2], t1[3]};
                o[nt] = __builtin_amdgcn_mfma_f32_16x16x32_bf16(va, pb, o[nt], 0, 0, 0);
            }
        }
        if (part == 1) { LAS float* mp = mrg + (qb * 64 + lane) * 18; mp[0] = mx; mp[1] = lsum;
#pragma unroll
            for (int nt = 0; nt < 4; ++nt)
#pragma unroll
                for (int j = 0; j < 4; ++j) mp[2 + 4 * nt + j] = o[nt][j]; }
        __syncthreads();
        if (part == 0) { const LAS float* mp = mrg + (qb * 64 + lane) * 18; const float m2 = mp[0], l2 = mp[1];
            const float M = fmaxf(mx, m2), f1 = __builtin_amdgcn_exp2f(mx - M), f2 = __builtin_amdgcn_exp2f(m2 - M), inv = 1.0f / (lsum * f1 + l2 * f2);
            const int mq = b * 2048 + r * 64 + 16 * qb + c;
            fp8* op = F_MIX + (size_t)mq * D + 384 + h * 64 + 4 * g;
#pragma unroll
            for (int nt = 0; nt < 4; ++nt) { float r4[4];
#pragma unroll
                for (int j = 0; j < 4; ++j) r4[j] = (o[nt][j] * f1 + mp[2 + 4 * nt + j] * f2) * inv;
                *(unsigned*)(op + 16 * nt) = pk4_fp8(r4[0], r4[1], r4[2], r4[3]); } }
    }
    __syncthreads();
#undef NA_LOAD
#undef NA_PUT
#undef NA_LOADQ
}

__device__ __forceinline__ void conv_unit(const Frame& F, int l, int mbase, int len, int t0) {
    LAS float* hcv = (LAS float*)F.lds;
    LAS float* ob = (LAS float*)(F.lds + 62 * 256 * 4);
    const int tid = F.tid, lane = F.lane;
    const bf16* px = F_PX;
    for (int ch = tid; ch < 62 * 32; ch += 512) { const int rr = ch >> 5, c8 = (ch & 31) * 8, t = t0 - 15 + rr;
        f32x4 lo = (f32x4){0.f, 0.f, 0.f, 0.f}, hi = lo;
        if (t >= 0 && t < len) { const bf16* p = px + (size_t)(mbase + t) * NPX; const u32x4 a = *(const u32x4*)(p + C_CV + c8), gt = *(const u32x4*)(p + C_CG + c8);
            lo[0] = bflo(a.x) * sigmoid_f(bflo(gt.x)); lo[1] = bfhi(a.x) * sigmoid_f(bfhi(gt.x)); lo[2] = bflo(a.y) * sigmoid_f(bflo(gt.y)); lo[3] = bfhi(a.y) * sigmoid_f(bfhi(gt.y));
            hi[0] = bflo(a.z) * sigmoid_f(bflo(gt.z)); hi[1] = bfhi(a.z) * sigmoid_f(bfhi(gt.z)); hi[2] = bflo(a.w) * sigmoid_f(bflo(gt.w)); hi[3] = bfhi(a.w) * sigmoid_f(bfhi(gt.w)); }
        *(LAS f32x4*)(hcv + rr * 256 + c8) = lo; *(LAS f32x4*)(hcv + rr * 256 + c8 + 4) = hi; }
    const int c = tid & 255, th = tid >> 8;
    float wv[31];
#pragma unroll
    for (int j = 0; j < 31; ++j) wv[j] = inptr(F, 15)[((size_t)l * 31 + j) * 256 + c];
    const float bias = inptr(F, 16)[l * 256 + c];
    __syncthreads();
    float acc[16];
#pragma unroll
    for (int i = 0; i < 16; ++i) acc[i] = bias;
#pragma unroll
    for (int rr = 0; rr < 46; ++rr) { const float x = hcv[(th * 16 + rr) * 256 + c];
#pragma unroll
        for (int i = 0; i < 16; ++i) { const int j = rr - i; if (j >= 0 && j < 31) acc[i] += x * wv[j]; } }
#pragma unroll
    for (int i = 0; i < 16; ++i) ob[(th * 16 + i) * 256 + c] = acc[i];
    __syncthreads();
    const f32x4 lg = *(const f32x4*)(inptr(F, 17) + l * 256 + 4 * lane), lb = *(const f32x4*)(inptr(F, 18) + l * 256 + 4 * lane);
#pragma unroll
    for (int k = 0; k < 4; ++k) { const int tt = F.wave * 4 + k; const f32x4 x = *(const LAS f32x4*)(ob + tt * 256 + 4 * lane);
        const float mean = wave_sum((x[0] + x[1]) + (x[2] + x[3]), lane) * (1.0f / 256.0f); const f32x4 d = x - mean;
        const float var = wave_sum((d[0] * d[0] + d[1] * d[1]) + (d[2] * d[2] + d[3] * d[3]), lane) * (1.0f / 256.0f); const float rstd = 1.0f / sqrtf(var + EPS);
        const f32x4 y = d * rstd * lg + lb;
        *(unsigned*)(F_MIX + (size_t)(mbase + t0 + tt) * D + 768 + 4 * lane) = pk4_fp8(silu_f(y[0]), silu_f(y[1]), silu_f(y[2]), silu_f(y[3])); }
    __syncthreads();
}

constexpr int GB_TOT = 0;
constexpr int GB_X = 6144;
constexpr int GB_V = 8192;
constexpr int GB_T = GB_V + 64 * 208;
constexpr int GB_SF = GB_T + 4 * 64 * 144, GB_SB = GB_SF + 64 * 208;
constexpr int VST = 208, TST = 144;
static_assert(GB_SB + 64 * VST <= SCR_BYTES, "GLA LDS map");
__device__ __forceinline__ void gla_chunk_info(int b, int cc, int& m0, bool& lat, int& rowpos, int& idxf, int& idxb) {
    lat = cc >= 4;
    if (lat) { const int cl = cc - 4; m0 = b * 2048 + cl * 64; rowpos = cl; idxf = 4 + cl; idxb = 4 + (31 - cl); }
    else { m0 = ML + b * 256 + cc * 64; rowpos = 0; idxf = cc; idxb = 3 - cc; }
}
__device__ __forceinline__ bf16x8 tr_pair(const LAS unsigned char* p0, const LAS unsigned char* p1) {
    const s16x4 t0 = __builtin_amdgcn_ds_read_tr16_b64_v4i16((LAS s16x4*)p0), t1 = __builtin_amdgcn_ds_read_tr16_b64_v4i16((LAS s16x4*)p1);
    return (bf16x8){t0[0], t0[1], t0[2], t0[3], t1[0], t1[1], t1[2], t1[3]};
}
template <bool G3>
__device__ __forceinline__ void gla_stage(const Frame& F, int l, int b, int h, int m0, bool lat, int rowpos, int idxf, int idxb) {
    int tid_ = F.tid; asm volatile("" : "+v"(tid_));
    const int tid = tid_; const bf16* px = F_PX;
    LAS float* TOT = (LAS float*)(F.lds + GB_TOT);
    const size_t chainf = ((size_t)(0 * 16 + b) * 4 + h), chainb = ((size_t)(1 * 16 + b) * 4 + h);
    if (tid >= 384) {
        const int at = tid - 384;
#pragma unroll
        for (int i = 0; i < 6; ++i) { const int idx = at + 128 * i, t = idx / 12, ch = idx % 12;
            *(LAS u32x4*)(F.lds + GB_V + t * VST + ch * 16) = *(const u32x4*)(px + (size_t)(m0 + t) * NPX + C_GV + h * 96 + ch * 8); }
        if constexpr (G3) {
            for (int i = at; i < 2 * 16 * 13; i += 128) { const int dir = i / 208, r = i % 208, d = 48 + r / 13, ch = r % 13; *(LAS u32x4*)(F.lds + (dir ? GB_SB : GB_SF) + d * VST + ch * 16) = (u32x4){0u, 0u, 0u, 0u}; }
            for (int i = at; i < 512; i += 128) { const int row = i >> 1, hf = i & 1; *(LAS u32x4*)(F.lds + GB_T + row * TST + 96 + hf * 16) = (u32x4){0u, 0u, 0u, 0u}; }
        }
    }
    u32x4 sx[3];
    if constexpr (G3) {
        const bf16* gf = F_GST + (chainf * NCH + idxf) * 4608; const bf16* gb = F_GST + (chainb * NCH + idxb) * 4608;
#pragma unroll
        for (int i = 0; i < 3; ++i) { const int idx = tid + 512 * i; if (idx < 1152) { const int dirs = idx / 576, rr = idx % 576; sx[i] = *(const u32x4*)((dirs ? gb : gf) + rr * 8); } }
    }
    float pr_[4][4]; float kk[4][4], qq[4][4];
    const int dir = (tid >= 192) ? 1 : 0, r_ = tid - 192 * dir, dg = r_ >> 4, tg = r_ & 15;
    float* pvg = F_PV + ((((size_t)(b * 4 + h) * NCH + idxf) * 2 + dir) * 64 + 4 * tg) * 48 + 4 * dg;
    f32x4 pvl[4];
    if (tid < 384) {
        u32x4 araw[4][2]; f32x4 wv[16]; f32x4 bav;
        if constexpr (!G3) {
#pragma unroll
        for (int t = 0; t < 4; ++t) { const bf16* ap = px + (size_t)(m0 + 4 * tg + t) * NPX + C_GA + 16 * dir; araw[t][0] = *(const u32x4*)ap; araw[t][1] = *(const u32x4*)(ap + 8); }
        const float* wa = inptr(F, dir ? 11 : 9) + (size_t)l * 16 * 192 + h * 48 + 4 * dg;
#pragma unroll
        for (int j = 0; j < 16; ++j) wv[j] = *(const f32x4*)(wa + j * 192);
        bav = *(const f32x4*)(inptr(F, dir ? 12 : 10) + l * 192 + h * 48 + 4 * dg);
        } else {
#pragma unroll
        for (int t = 0; t < 4; ++t) pvl[t] = *(const f32x4*)(pvg + t * 48);
        }
        u32x2 kraw[4], qraw[4];
#pragma unroll
        for (int t = 0; t < 4; ++t) { const bf16* rp = px + (size_t)(m0 + 4 * tg + t) * NPX + h * 48 + 4 * dg; kraw[t] = *(const u32x2*)(rp + C_GK); if constexpr (G3) qraw[t] = *(const u32x2*)(rp + C_GQ); }
        f32x4 rope[4];
        if (lat) {
#pragma unroll
            for (int t = 0; t < 4; ++t) { const int pos = (dg < 6) ? rowpos : (4 * tg + t), j = (dg < 6) ? 2 * dg : 2 * dg - 12; rope[t] = *(const f32x4*)(F_ROPE + (pos * 12 + j) * 2); }
        }
        if constexpr (!G3) {
#pragma unroll
        for (int t = 0; t < 4; ++t) {
            float a[16];
#pragma unroll
            for (int i = 0; i < 4; ++i) { const unsigned w0 = araw[t][i >> 1][(i & 1) * 2], w1 = araw[t][i >> 1][(i & 1) * 2 + 1]; a[4 * i] = bflo(w0); a[4 * i + 1] = bfhi(w0); a[4 * i + 2] = bflo(w1); a[4 * i + 3] = bfhi(w1); }
            f32x4 x = bav;
#pragma unroll
            for (int j = 0; j < 16; ++j) x += wv[j] * a[j];
            { constexpr float L2E = 1.4426950408889634f;
              f32x4 tt; tt[0] = fabsf(x[0]); tt[1] = fabsf(x[1]); tt[2] = fabsf(x[2]); tt[3] = fabsf(x[3]); tt = tt * (-L2E);
              f32x4 ee; ee[0] = __builtin_amdgcn_exp2f(tt[0]); ee[1] = __builtin_amdgcn_exp2f(tt[1]); ee[2] = __builtin_amdgcn_exp2f(tt[2]); ee[3] = __builtin_amdgcn_exp2f(tt[3]);
              const f32x4 uu = ee + 1.0f;
              f32x4 lg; lg[0] = __builtin_amdgcn_logf(uu[0]); lg[1] = __builtin_amdgcn_logf(uu[1]); lg[2] = __builtin_amdgcn_logf(uu[2]); lg[3] = __builtin_amdgcn_logf(uu[3]);
              f32x4 mn; mn[0] = fminf(x[0], 0.f); mn[1] = fminf(x[1], 0.f); mn[2] = fminf(x[2], 0.f); mn[3] = fminf(x[3], 0.f);
              const f32x4 pr4 = mn * (0.0625f * L2E) - lg * 0.0625f;
              pr_[t][0] = pr4[0]; pr_[t][1] = pr4[1]; pr_[t][2] = pr4[2]; pr_[t][3] = pr4[3]; }
        }
        if (dir == 0) {
#pragma unroll
            for (int t = 1; t < 4; ++t)
#pragma unroll
                for (int d = 0; d < 4; ++d) pr_[t][d] += pr_[t - 1][d];
            *(LAS f32x4*)(TOT + (0 * 16 + tg) * 48 + 4 * dg) = (f32x4){pr_[3][0], pr_[3][1], pr_[3][2], pr_[3][3]};
        } else {
#pragma unroll
            for (int t = 2; t >= 0; --t)
#pragma unroll
                for (int d = 0; d < 4; ++d) pr_[t][d] += pr_[t + 1][d];
            *(LAS f32x4*)(TOT + (1 * 16 + tg) * 48 + 4 * dg) = (f32x4){pr_[0][0], pr_[0][1], pr_[0][2], pr_[0][3]};
        }
        }
#pragma unroll
        for (int t = 0; t < 4; ++t) {
            kk[t][0] = bflo(kraw[t].x); kk[t][1] = bfhi(kraw[t].x); kk[t][2] = bflo(kraw[t].y); kk[t][3] = bfhi(kraw[t].y);
            if constexpr (G3) { qq[t][0] = bflo(qraw[t].x) * 0.14433756729740643f; qq[t][1] = bfhi(qraw[t].x) * 0.14433756729740643f; qq[t][2] = bflo(qraw[t].y) * 0.14433756729740643f; qq[t][3] = bfhi(qraw[t].y) * 0.14433756729740643f; }
            if (lat) {
#pragma unroll
                for (int pp = 0; pp < 2; ++pp) { const float cs = rope[t][2 * pp], sn = rope[t][2 * pp + 1];
                    const float k1 = kk[t][2 * pp], k2 = kk[t][2 * pp + 1]; kk[t][2 * pp] = k1 * cs - k2 * sn; kk[t][2 * pp + 1] = k1 * sn + k2 * cs;
                    if constexpr (G3) { const float q1 = qq[t][2 * pp], q2 = qq[t][2 * pp + 1]; qq[t][2 * pp] = q1 * cs - q2 * sn; qq[t][2 * pp + 1] = q1 * sn + q2 * cs; } }
            }
        }
    }
    if constexpr (G3) {
#pragma unroll
        for (int i = 0; i < 3; ++i) { const int idx = tid + 512 * i; if (idx < 1152) { const int dirs = idx / 576, rr = idx % 576, d = rr / 12, e8 = (rr % 12) * 8;
            *(LAS u32x4*)(F.lds + (dirs ? GB_SB : GB_SF) + d * VST + e8 * 2) = sx[i]; } }
    }
    __syncthreads();
    if (tid < 384) {
        f32x4 off = (f32x4){0.f, 0.f, 0.f, 0.f}, E = off;
        if constexpr (!G3) {
        f32x4 tvs[16];
#pragma unroll
        for (int g2 = 0; g2 < 16; ++g2) tvs[g2] = *(const LAS f32x4*)(TOT + (dir * 16 + g2) * 48 + 4 * dg);
#pragma unroll
        for (int g2 = 0; g2 < 16; ++g2) { const float mk = (dir == 0 ? (g2 < tg) : (g2 > tg)) ? 1.0f : 0.0f; E += tvs[g2]; off += tvs[g2] * mk; }
        }
        LAS unsigned char* base = F.lds + GB_T + (4 * tg) * TST + 8 * dg;
#pragma unroll
        for (int t = 0; t < 4; ++t) {
            float pv[4];
            if constexpr (G3) {
#pragma unroll
                for (int d = 0; d < 4; ++d) pv[d] = pvl[t][d];
            } else {
#pragma unroll
                for (int d = 0; d < 4; ++d) pv[d] = pr_[t][d] + off[d];
                *(f32x4*)(pvg + t * 48) = (f32x4){pv[0], pv[1], pv[2], pv[3]};
            }
            if constexpr (G3) {
                u32x2 wq, wk; wq.x = cvt_pk_bf16(qq[t][0] * __builtin_amdgcn_exp2f(pv[0]), qq[t][1] * __builtin_amdgcn_exp2f(pv[1])); wq.y = cvt_pk_bf16(qq[t][2] * __builtin_amdgcn_exp2f(pv[2]), qq[t][3] * __builtin_amdgcn_exp2f(pv[3]));
                wk.x = cvt_pk_bf16(kk[t][0] * __builtin_amdgcn_exp2f(-pv[0]), kk[t][1] * __builtin_amdgcn_exp2f(-pv[1])); wk.y = cvt_pk_bf16(kk[t][2] * __builtin_amdgcn_exp2f(-pv[2]), kk[t][3] * __builtin_amdgcn_exp2f(-pv[3]));
                *(LAS u32x2*)(base + (dir * 64 + t) * TST) = wq; *(LAS u32x2*)(base + ((2 + dir) * 64 + t) * TST) = wk;
            } else {
                u32x2 wk; wk.x = cvt_pk_bf16(kk[t][0] * __builtin_amdgcn_exp2f(E[0] - pv[0]), kk[t][1] * __builtin_amdgcn_exp2f(E[1] - pv[1])); wk.y = cvt_pk_bf16(kk[t][2] * __builtin_amdgcn_exp2f(E[2] - pv[2]), kk[t][3] * __builtin_amdgcn_exp2f(E[3] - pv[3]));
                *(LAS u32x2*)(base + ((2 + dir) * 64 + t) * TST) = wk;
            }
        }
        if constexpr (!G3) { if (tg == 0) *(f32x4*)(F_DECAY + ((dir ? chainb : chainf) * NCH + (dir ? idxb : idxf)) * 48 + 4 * dg) = (f32x4){__builtin_amdgcn_exp2f(E[0]), __builtin_amdgcn_exp2f(E[1]), __builtin_amdgcn_exp2f(E[2]), __builtin_amdgcn_exp2f(E[3])}; }
    }
    __syncthreads();
}
__device__ __forceinline__ void gla_g1_unit(const Frame& F, int l, int b, int h, int cc) {
    int m0, rowpos, idxf, idxb; bool lat; gla_chunk_info(b, cc, m0, lat, rowpos, idxf, idxb);
    gla_stage<false>(F, l, b, h, m0, lat, rowpos, idxf, idxb);
    const int lane = F.lane, w = F.wave, g = lane >> 4, c = lane & 15;
    const size_t chainf = ((size_t)(0 * 16 + b) * 4 + h), chainb = ((size_t)(1 * 16 + b) * 4 + h);
    const int q = c >> 2, p = c & 3;
    for (int T = w; T < 36; T += 8) { const int dir = T / 18, rem = T % 18, dt = rem / 6, et = rem % 6;
        const LAS unsigned char* KH = F.lds + GB_T + (2 + dir) * 64 * TST; const LAS unsigned char* Vb = F.lds + GB_V;
        f32x4 acc = (f32x4){0.f, 0.f, 0.f, 0.f};
#pragma unroll
        for (int ks = 0; ks < 2; ++ks) { const int tr0 = 32 * ks + 8 * g + q;
            const bf16x8 ka = tr_pair(KH + tr0 * TST + (16 * dt + 4 * p) * 2, KH + (tr0 + 4) * TST + (16 * dt + 4 * p) * 2);
            const bf16x8 vb = tr_pair(Vb + tr0 * VST + (16 * et + 4 * p) * 2, Vb + (tr0 + 4) * VST + (16 * et + 4 * p) * 2);
            acc = __builtin_amdgcn_mfma_f32_16x16x32_bf16(ka, vb, acc, 0, 0, 0); }
        bf16* gp = F_GST + ((dir ? chainb : chainf) * NCH + (dir ? idxb : idxf)) * 4608 + (size_t)(16 * dt + 4 * g) * 96 + 16 * et + c;
#pragma unroll
        for (int j = 0; j < 4; ++j) gp[j * 96] = (bf16)(cvt_pk_bf16(acc[j], 0.f) & 0xffffu); }
    __syncthreads();
}
__device__ __forceinline__ void phase_gla_g2(const Frame& F) {
    const int n = 2 * 16 * 4 * 2304;
    for (int i = F.bid * 512 + F.tid; i < n; i += F.G * 512) { const int chain = i / 2304, de2 = i % 2304, d = de2 / 48;
        unsigned* base = (unsigned*)(F_GST + (size_t)chain * NCH * 4608) + de2; const float* dc = F_DECAY + (size_t)chain * NCH * 48 + d;
        unsigned tv[NCH]; float dv[NCH];
#pragma unroll
        for (int c = 0; c < NCH; ++c) { tv[c] = base[(size_t)c * 2304]; dv[c] = dc[c * 48]; }
        float r0 = 0.f, r1 = 0.f;
#pragma unroll
        for (int c = 0; c < NCH; ++c) { const float t0 = bflo(tv[c]), t1 = bfhi(tv[c]); tv[c] = cvt_pk_bf16(r0, r1); r0 = dv[c] * r0 + t0; r1 = dv[c] * r1 + t1; }
#pragma unroll
        for (int c = 0; c < NCH; ++c) base[(size_t)c * 2304] = tv[c]; }
}
__device__ __forceinline__ void gla_g3_unit(const Frame& F, int l, int b, int h, int cc) {
    LAS float* ssx = (LAS float*)(F.lds + GB_X);
    int m0, rowpos, idxf, idxb; bool lat; gla_chunk_info(b, cc, m0, lat, rowpos, idxf, idxb);
    gla_stage<true>(F, l, b, h, m0, lat, rowpos, idxf, idxb);
    const int lane = F.lane, w = F.wave, g = lane >> 4, c = lane & 15;
    const int tt = w & 3, eh = w >> 2, q = c >> 2, p = c & 3;
    const int mrow = m0 + 16 * tt + c; const float* gn = inptr(F, 13) + l * 384 + h * 96;
    u32x2 gtv[3]; f32x4 gnv[3];
#pragma unroll
    for (int k = 0; k < 3; ++k) { const int e = 16 * (3 * eh + k) + 4 * g; gtv[k] = *(const u32x2*)(F_PX + (size_t)mrow * NPX + C_GG + h * 96 + e); gnv[k] = *(const f32x4*)(gn + e); }
    const LAS unsigned char* QFb = F.lds + GB_T; const LAS unsigned char* QBb = QFb + 64 * TST; const LAS unsigned char* KFb = QFb + 128 * TST; const LAS unsigned char* KBb = QFb + 192 * TST;
    const bf16x8 qf0 = *(const LAS bf16x8*)(QFb + (16 * tt + c) * TST + 16 * g), qf1 = *(const LAS bf16x8*)(QFb + (16 * tt + c) * TST + 64 + 16 * g);
    const bf16x8 qb0 = *(const LAS bf16x8*)(QBb + (16 * tt + c) * TST + 16 * g), qb1 = *(const LAS bf16x8*)(QBb + (16 * tt + c) * TST + 64 + 16 * g);
    f32x4 at[4];
#pragma unroll
    for (int si = 0; si < 4; ++si) {
        f32x4 zf = (f32x4){0.f, 0.f, 0.f, 0.f}, zb = zf;
        if (si <= tt) { const bf16x8 k0 = *(const LAS bf16x8*)(KFb + (16 * si + c) * TST + 16 * g), k1 = *(const LAS bf16x8*)(KFb + (16 * si + c) * TST + 64 + 16 * g);
            zf = __builtin_amdgcn_mfma_f32_16x16x32_bf16(k0, qf0, zf, 0, 0, 0); zf = __builtin_amdgcn_mfma_f32_16x16x32_bf16(k1, qf1, zf, 0, 0, 0); }
        if (si >= tt) { const bf16x8 k0 = *(const LAS bf16x8*)(KBb + (16 * si + c) * TST + 16 * g), k1 = *(const LAS bf16x8*)(KBb + (16 * si + c) * TST + 64 + 16 * g);
            zb = __builtin_amdgcn_mfma_f32_16x16x32_bf16(k0, qb0, zb, 0, 0, 0); zb = __builtin_amdgcn_mfma_f32_16x16x32_bf16(k1, qb1, zb, 0, 0, 0); }
        if (si == tt) {
#pragma unroll
            for (int j = 0; j < 4; ++j) { const int sl = 4 * g + j; at[si][j] = (sl <= c ? zf[j] : 0.f) + (sl >= c ? zb[j] : 0.f); } }
        else at[si] = zf + zb;
    }
    f32x4 o[3];
#pragma unroll
    for (int k = 0; k < 3; ++k) o[k] = (f32x4){0.f, 0.f, 0.f, 0.f};
    const LAS unsigned char* Vb = F.lds + GB_V; const LAS unsigned char* SFb = F.lds + GB_SF; const LAS unsigned char* SBb = F.lds + GB_SB;
#pragma unroll
    for (int ks = 0; ks < 2; ++ks) {
        bf16x8 pb; { u32x4 pw = (u32x4){cvt_pk_bf16(at[2 * ks][0], at[2 * ks][1]), cvt_pk_bf16(at[2 * ks][2], at[2 * ks][3]), cvt_pk_bf16(at[2 * ks + 1][0], at[2 * ks + 1][1]), cvt_pk_bf16(at[2 * ks + 1][2], at[2 * ks + 1][3])}; pb = __builtin_bit_cast(bf16x8, pw); }
#pragma unroll
        for (int k = 0; k < 3; ++k) { const int et = 3 * eh + k;
            const bf16x8 va = tr_pair(Vb + (32 * ks + 4 * g + q) * VST + (16 * et + 4 * p) * 2, Vb + (32 * ks + 16 + 4 * g + q) * VST + (16 * et + 4 * p) * 2);
            o[k] = __builtin_amdgcn_mfma_f32_16x16x32_bf16(va, pb, o[k], 0, 0, 0); }
    }
#pragma unroll
    for (int kd = 0; kd < 2; ++kd) {
#pragma unroll
        for (int k = 0; k < 3; ++k) { const int et = 3 * eh + k;
            const bf16x8 sa = tr_pair(SFb + (32 * kd + 8 * g + q) * VST + (16 * et + 4 * p) * 2, SFb + (32 * kd + 8 * g + 4 + q) * VST + (16 * et + 4 * p) * 2);
            o[k] = __builtin_amdgcn_mfma_f32_16x16x32_bf16(sa, kd ? qf1 : qf0, o[k], 0, 0, 0);
            const bf16x8 sb = tr_pair(SBb + (32 * kd + 8 * g + q) * VST + (16 * et + 4 * p) * 2, SBb + (32 * kd + 8 * g + 4 + q) * VST + (16 * et + 4 * p) * 2);
            o[k] = __builtin_amdgcn_mfma_f32_16x16x32_bf16(sb, kd ? qb1 : qb0, o[k], 0, 0, 0); }
    }
    float ss = 0.f;
#pragma unroll
    for (int k = 0; k < 3; ++k) ss += (o[k][0] * o[k][0] + o[k][1] * o[k][1]) + (o[k][2] * o[k][2] + o[k][3] * o[k][3]);
    ss += shx(ss, 16, lane); ss += shx(ss, 32, lane);
    if (g == 0) ssx[w * 16 + c] = ss;
    __syncthreads();
    const float tot = ssx[w * 16 + c] + ssx[(w ^ 4) * 16 + c];
    const float rstd = 1.0f / sqrtf(tot * (1.0f / 96.0f) + EPS);
    const int m = mrow;
#pragma unroll
    for (int k = 0; k < 3; ++k) { const int e = 16 * (3 * eh + k) + 4 * g;
        const u32x2 gt = gtv[k]; const f32x4 gv = gnv[k];
        *(unsigned*)(F_MIX + (size_t)m * D + h * 96 + e) = pk4_fp8(o[k][0] * rstd * gv[0] * silu_f(bflo(gt.x)), o[k][1] * rstd * gv[1] * silu_f(bfhi(gt.x)), o[k][2] * rstd * gv[2] * silu_f(bflo(gt.y)), o[k][3] * rstd * gv[3] * silu_f(bfhi(gt.y))); }
    __syncthreads();
}

__device__ __forceinline__ void phase_final(const Frame& F) {
    const int gw = F.bid * 8 + F.wave, NGW = F.G * 8, lane = F.lane;
    f32x4 gm[4];
#pragma unroll
    for (int j = 0; j < 4; ++j) gm[j] = *(const f32x4*)(inptr(F, 25) + 4 * lane + 256 * j);
    moe_tilebase_to_lds(F, DEPTH - 1);
    for (int m = gw; m < ML; m += NGW) {
        const int b = m >> 11; float* xr = F.out + (size_t)m * D; const bf16* xb = F_XB + (size_t)m * D;
        f32x4 v[4];
#pragma unroll
        for (int j = 0; j < 4; ++j) v[j] = bf4(*(const u32x2*)(xb + 4 * lane + 256 * j));
        const float* g5 = F_MOD + ((size_t)(DEPTH - 1) * 17 + b) * 6144 + 5 * 1024;
        const float w0 = F_SLOTW[2 * m] * 0.0625f, w1 = F_SLOTW[2 * m + 1] * 0.0625f;
        const fp8* y0 = F_YBUF + (size_t)moe_slot_row(F, 2 * m) * D; const fp8* y1 = F_YBUF + (size_t)moe_slot_row(F, 2 * m + 1) * D;
        float ss = 0.f;
#pragma unroll
        for (int j = 0; j < 4; ++j) { const f32x4 a = fp84(*(const unsigned*)(y0 + 4 * lane + 256 * j)), c = fp84(*(const unsigned*)(y1 + 4 * lane + 256 * j)); const f32x4 g = *(const f32x4*)(g5 + 4 * lane + 256 * j);
            v[j] += g * (a * w0 + c * w1);
            ss += (v[j][0] * v[j][0] + v[j][1] * v[j][1]) + (v[j][2] * v[j][2] + v[j][3] * v[j][3]); }
        const float rstd = 1.0f / sqrtf(wave_sum(ss, lane) * (1.0f / D) + EPS);
#pragma unroll
        for (int j = 0; j < 4; ++j) *(f32x4*)(xr + 4 * lane + 256 * j) = v[j] * rstd * gm[j];
    }
}

constexpr int NPL = 9, NPHASE = 1 + DEPTH * NPL + 1;
struct Args { const float* in[26]; float* out; unsigned char* ws; int ph_lo, ph_hi; };
#define IN(k) (lo <= (k) && (k) < hi)
#if MK_PER_PHASE
#define SEAM(k) do { } while (0)
#else
#define SEAM(k) do { if (IN(k) && IN((k) + 1)) { XcdBarrier _bb = bar; GAS unsigned* _bp = (GAS unsigned*)(args.ws + WS_CTL) + CW_BAR; asm volatile("" : "+s"(_bp)); _bb.bar = (unsigned*)_bp; xcd_barrier(_bb); if (DUP & 8192) xcd_barrier(_bb); } } while (0)
#endif
#define FRESH() do { int _t = threadIdx.x; asm volatile("" : "+v"(_t)); F.tid = _t; F.lane = _t & 63; F.wave = __builtin_amdgcn_readfirstlane(_t >> 6); \
        GAS unsigned char* _w = (GAS unsigned char*)args.ws; GAS float* _o = (GAS float*)args.out; int _g = gridDim.x, _b = blockIdx.x; asm volatile("" : "+s"(_w), "+s"(_o), "+s"(_g), "+s"(_b)); F.ws = (unsigned char*)_w; F.out = (float*)_o; F.G = _g; F.bid = _b; } while (0)

template <int l>
__device__ __forceinline__ void layer_body(Frame& F, const Args& args, const int lo, const int hi, const XcdBarrier& bar) {
    constexpr int pb = 1 + l * NPL; constexpr bool lastl = (l == DEPTH - 1);
    if (IN(pb + 0) && (EN & 2)) { FRESH(); if (DUP & 2) { phase_norm1<true>(F, l); __syncthreads(); } phase_norm1(F, l); router_fold(F, l); } SEAM(pb + 0);
    if (IN(pb + 1) && (EN & 4)) { FRESH(); pg8::Gemm g{F_HX8, F_WIN + (size_t)l * NPX * D, D}; pg8::StaticOrder S; S.init(MT, NPX, F.G, F.bid); EpiPx E{F_PX, F.ws};
        pg8::gemm_phase<EpiPx, pg8::StaticOrder, true, false, true>(F.lds, g, S, E); if (DUP & 4) pg8::gemm_phase<EpiPx, pg8::StaticOrder, true, false, true>(F.lds, g, S, E); } SEAM(pb + 1);
    if (IN(pb + 2)) {
        XcdBarrier sb = bar; { GAS unsigned* _bp = (GAS unsigned*)(args.ws + WS_CTL) + CW_BAR; asm volatile("" : "+s"(_bp)); sb.bar = (unsigned*)_bp; }
        GAS unsigned* _sp = (GAS unsigned*)(args.ws + WS_CTL) + CW_SPL + 4096 * l; asm volatile("" : "+s"(_sp)); unsigned* slotA = (unsigned*)_sp; unsigned* slotB = slotA + 2048;
#define MIX_CONV(k) do { if constexpr (l == 0) { if ((int)(F.bid % 5) == (k)) { FRESH(); __syncthreads(); moe_convert(F, 0, F.bid, F.G); __syncthreads(); } } } while (0)
        MIX_CONV(0);
        FRESH();
        if (EN & 8) for (int rep = 0; rep < ((DUP & 8) ? 2 : 1); ++rep)
        for (int u = F.bid; u < 16 * 4 * NCH; u += F.G) { const int cc = u % NCH, bh = u / NCH; gla_g1_unit(F, l, bh >> 2, bh & 3, cc); }
        xcd_arrive(sb, slotA);
        MIX_CONV(1);
        FRESH();
        if (EN & 16) for (int rep = 0; rep < ((DUP & 16) ? 2 : 1); ++rep)
        if (F.G == 256) {
            na_latent_phase(F, l);
        } else
        for (int u = F.bid; u < 16 * 6 * 32; u += F.G) { const int r = u & 31, bh = u >> 5; na_unit(F, l, 0, bh / 6, bh % 6, r); }
        if ((EN & 16) && !lastl) for (int u = F.bid; u < 16 * 6 * 4; u += F.G) { const int qb = u & 3, bh = u >> 2; na_unit(F, l, 1, bh / 6, bh % 6, qb); }
        MIX_CONV(2);
        xcd_wait(sb, slotA);
        if (EN & 64) { FRESH(); phase_gla_g2(F); }
        xcd_arrive(sb, slotB);
        MIX_CONV(3);
        FRESH();
        if (EN & 32) for (int rep = 0; rep < ((DUP & 32) ? 2 : 1); ++rep)
        for (int u = F.bid; u < 16 * 64; u += F.G) conv_unit(F, l, (u >> 6) * 2048, 2048, (u & 63) * 32);
        if ((EN & 32) && !lastl) for (int u = (F.G == 256) ? (F.bid + 128) % 256 : F.bid; u < 16 * 8; u += F.G) conv_unit(F, l, ML + (u >> 3) * 256, 256, (u & 7) * 32);
        MIX_CONV(4);
#undef MIX_CONV
        xcd_wait(sb, slotB);
        if (EN & 128) { FRESH(); for (int rep = 0; rep < ((DUP & 128) ? 2 : 1); ++rep) for (int u = F.bid; u < 16 * 4 * NCH; u += F.G) { const int cc = u % NCH, bh = u / NCH; if (lastl && cc < 4) continue; gla_g3_unit(F, l, bh >> 2, bh & 3, cc); } }
    } SEAM(pb + 4);
    if (IN(pb + 5) && (EN & 256)) { FRESH(); pg8::Gemm g{F_MIX, F_WOUT + (size_t)l * D * D, D}; SplitOrder S; S.base.init(lastl ? ML : MT, D, F.G, F.bid);
        EpiResid<l == 0> E{inptr(F, 0), inptr(F, 2), F_XB, F_MOD + (size_t)l * 17 * 6144};
        int split = 1 << 20;
        if constexpr (!lastl) { if (F.G == 256 && F.bid >= 64) split = (F.bid - 64) % 3; }
        S.i0 = 0; S.i1 = split;
        pg8::gemm_phase<EpiResid<l == 0>, SplitOrder, true, false, true>(F.lds, g, S, E);
        if constexpr (!lastl) {
            if (F.G == 256) { if (F.bid >= 64) { __syncthreads(); moe_convert(F, l + 1, F.bid - 64, 192); } } else moe_convert(F, l + 1, F.bid, F.G);
            if (split < 2) { __syncthreads(); S.i0 = split; S.i1 = 1 << 20; pg8::gemm_phase<EpiResid<l == 0>, SplitOrder, true, false, true>(F.lds, g, S, E); } } } SEAM(pb + 5);
    if (IN(pb + 6) && (EN & 512)) { FRESH(); phase_norm2_router(F, l); } SEAM(pb + 6);
    if (IN(pb + 7) && (EN & 1024)) { FRESH(); MoeOrder S; moe_setup(F, l, S, 8); pg8::Gemm g{F_HX8, F_WGU + (size_t)l * NE * 2048 * D, D}; EpiSwiGLU E{F_ACT};
        pg8::gemm_phase<EpiSwiGLU, MoeOrder, true, true, true>(F.lds, g, S, E); if (DUP & 1024) pg8::gemm_phase<EpiSwiGLU, MoeOrder, true, true, true>(F.lds, g, S, E); } SEAM(pb + 7);
    if (IN(pb + 8) && (EN & 2048)) { FRESH(); MoeOrder S; moe_setup(F, l, S, 4); pg8::Gemm g{F_ACT, F_WD + (size_t)l * NE * D * D, D}; EpiYrow E{F_YBUF};
        pg8::gemm_phase<EpiYrow, MoeOrder, true, false, true>(F.lds, g, S, E); if (DUP & 2048) pg8::gemm_phase<EpiYrow, MoeOrder, true, false, true>(F.lds, g, S, E); } SEAM(pb + 8);
}

__global__ void __launch_bounds__(512, 2) fwd_kernel(Args args) {
    extern __shared__ __attribute__((aligned(16))) unsigned char lds_raw[];
    Frame F;
    F.lds = (LAS unsigned char*)lds_raw;
    F.tid = threadIdx.x; F.lane = F.tid & 63; F.wave = __builtin_amdgcn_readfirstlane(F.tid >> 6); F.G = gridDim.x; F.bid = blockIdx.x;
    F.out = args.out; F.ws = args.ws;
    if (F.tid < 26) { const unsigned long long p = (unsigned long long)args.in[F.tid]; LAS unsigned* t = (LAS unsigned*)(F.lds + LDS_PTR) + 2 * F.tid; t[0] = (unsigned)p; t[1] = (unsigned)(p >> 32); }
    volatile LAS unsigned* MISC = (volatile LAS unsigned*)(F.lds + LDS_MISC);
    if (F.tid < 64) MISC[F.tid] = 0u;
    __syncthreads();
#if MK_PER_PHASE
    XcdBarrier bar; bar.bar = nullptr; bar.x = 0; bar.st = nullptr;
#else
    XcdBarrier bar = xcd_barrier_post(F_CTL + CW_BAR, MISC + 8);
#endif
    const int lo = args.ph_lo, hi = args.ph_hi;
    if (IN(0) && (EN & 1)) { FRESH(); phase_prologue(F); if (DUP & 1) { __syncthreads(); phase_prologue(F); } } SEAM(0);
    layer_body<0>(F, args, lo, hi, bar);
    layer_body<1>(F, args, lo, hi, bar);
    layer_body<2>(F, args, lo, hi, bar);
    layer_body<3>(F, args, lo, hi, bar);
    if (IN(NPHASE - 1) && (EN & 4096)) { FRESH(); phase_final(F); }
}
#undef IN
#undef SEAM
#undef FRESH

extern "C" void kernel_launch(void* const* d_in, const int* in_sizes, int n_in, void* d_out, int out_size, void* d_ws, size_t ws_size, hipStream_t stream) {
    static int grid = 0;
    if (grid == 0) {
        if (n_in != 26 || out_size != ML * D || ws_size < WS_END) { fprintf(stderr, "kernel_launch: unexpected problem shape (n_in %d out %d ws %zu)\n", n_in, out_size, ws_size); grid = -1; return; }
        int dev = 0, cus = 0, per_cu = 0;
        if (hipGetDevice(&dev) != hipSuccess || hipDeviceGetAttribute(&cus, hipDeviceAttributeMultiprocessorCount, dev) != hipSuccess) { grid = -1; return; }
        if (hipFuncSetAttribute((const void*)fwd_kernel, hipFuncAttributeMaxDynamicSharedMemorySize, LDS_BYTES) != hipSuccess) { fprintf(stderr, "kernel_launch: hipFuncSetAttribute failed\n"); grid = -1; return; }
        if (hipOccupancyMaxActiveBlocksPerMultiprocessor(&per_cu, (const void*)fwd_kernel, 512, LDS_BYTES) != hipSuccess || per_cu < 1) { fprintf(stderr, "kernel_launch: occupancy query says %d\n", per_cu); }
        (void)hipGetLastError();
        grid = cus;
    }
    if (grid < 0) return;
    (void)hipMemsetAsync((char*)d_ws + WS_CTL, 0, CTL_ZERO_BYTES, stream);
    Args a{};
    for (int i = 0; i < 26; ++i) a.in[i] = (const float*)d_in[i];
    a.out = (float*)d_out; a.ws = (unsigned char*)d_ws;
#if MK_PER_PHASE
    for (int p = 0; p < NPHASE; ++p) { a.ph_lo = p; a.ph_hi = p + 1; hipLaunchKernelGGL(fwd_kernel, dim3(grid), dim3(512), LDS_BYTES, stream, a); }
#else
    a.ph_lo = 0; a.ph_hi = NPHASE; hipLaunchKernelGGL(fwd_kernel, dim3(grid), dim3(512), LDS_BYTES, stream, a);
#endif
}
```

```cpp
#include <hip/hip_runtime.h>
#include <cstdio>
#include <cstdint>

#ifndef EN
#define EN 0xffff
#endif
#ifndef DUP
#define DUP 0
#endif
#ifndef MK_PER_PHASE
#define MK_PER_PHASE 0
#endif

#define GAS __attribute__((address_space(1)))
#define LAS __attribute__((address_space(3)))
typedef unsigned short bf16;
typedef float f32x4 __attribute__((ext_vector_type(4)));
typedef float f32x2 __attribute__((ext_vector_type(2)));
typedef short bf16x8 __attribute__((ext_vector_type(8)));
typedef short s16x4 __attribute__((ext_vector_type(4)));
typedef unsigned u32x4 __attribute__((ext_vector_type(4)));
typedef unsigned u32x2 __attribute__((ext_vector_type(2)));
typedef int i32x8 __attribute__((ext_vector_type(8)));
typedef int i32x4 __attribute__((ext_vector_type(4)));
typedef unsigned char fp8;

constexpr int D = 1024, NBATCH = 16, SEQ = 2048, CTXL = 256, DEPTH = 4;
constexpr int ML = NBATCH * SEQ, MC = NBATCH * CTXL, MT = ML + MC;
constexpr int NIN = 2848, NPX = 3072;
constexpr int C_GQ = 0, C_GK = 192, C_GV = 384, C_GG = 768, C_GA = 1152, C_NQ = 1184, C_NK = 1568, C_NV = 1952, C_CV = 2336, C_CG = 2592;
constexpr int NE = 16, NSLOT = 2 * MT;
constexpr int NCH = 36;
constexpr float EPS = 1e-6f;

constexpr size_t MiB = 1u << 20;
constexpr size_t WS_CTL = 0, CTL_ZERO_BYTES = 1 * MiB;
constexpr size_t WS_MOD = 1 * MiB;
constexpr size_t WS_ROPE = 3 * MiB;
constexpr size_t WS_DECAY = 4 * MiB;
constexpr size_t WS_WIN = 5 * MiB;
constexpr size_t WS_WOUT = 29 * MiB;
constexpr size_t WS_WGU = 37 * MiB;
constexpr size_t WS_XB = 165 * MiB;
constexpr size_t WS_RWP = 237 * MiB;
constexpr size_t WS_WD = 293 * MiB;
constexpr size_t WS_HX = 421 * MiB;
constexpr size_t WS_PX = 493 * MiB;
constexpr size_t WS_MIX = 709 * MiB;
constexpr size_t WS_GST = 781 * MiB;
constexpr size_t WS_XC = 862 * MiB;
constexpr size_t WS_LIST = 878 * MiB;
constexpr size_t WS_PV = 881 * MiB;
constexpr size_t WS_END = 936 * MiB;
constexpr int CW_TMO = 0, CW_BAR = 4096, CW_MOE = 8192, CW_SPL = 24576;

constexpr int SCR_BYTES = 139264;
constexpr int LDS_MISC = SCR_BYTES;
constexpr int LDS_PTR = LDS_MISC + 256;
constexpr int LDS_MOE = LDS_PTR + 256;
constexpr int LDS_ROWS = LDS_MOE + 256;
constexpr int MAXU = 12;
constexpr int LDS_BYTES = 152576;
static_assert(LDS_ROWS + MAXU * 1024 <= LDS_BYTES, "LDS map");

typedef __bf16 bf16x2_t __attribute__((ext_vector_type(2)));
__device__ __forceinline__ unsigned cvt_pk_bf16(float lo, float hi) { const bf16x2_t v = {(__bf16)lo, (__bf16)hi}; return __builtin_bit_cast(unsigned, v); }
__device__ __forceinline__ float bflo(unsigned w) { return __uint_as_float(w << 16); }
__device__ __forceinline__ float bfhi(unsigned w) { return __uint_as_float(w & 0xffff0000u); }
__device__ __forceinline__ f32x4 bf4(u32x2 w) { return (f32x4){bflo(w.x), bfhi(w.x), bflo(w.y), bfhi(w.y)}; }
__device__ __forceinline__ float bf2f(bf16 b) { return __uint_as_float((unsigned)b << 16); }
__device__ __forceinline__ float shx(float v, int o, int lane) { return __int_as_float(__builtin_amdgcn_ds_bpermute((lane ^ o) << 2, __float_as_int(v))); }
__device__ __forceinline__ float wave_sum(float v, int lane) {
#pragma unroll
    for (int o = 1; o < 64; o <<= 1) v += shx(v, o, lane);
    return v;
}
__device__ __forceinline__ f32x4 fp84(unsigned w) { const auto lo = __builtin_amdgcn_cvt_pk_f32_fp8((int)w, false); const auto hi = __builtin_amdgcn_cvt_pk_f32_fp8((int)w, true); return (f32x4){lo[0], lo[1], hi[0], hi[1]}; }
__device__ __forceinline__ unsigned pk4_fp8(float a, float b, float c, float d) { int p = __builtin_amdgcn_cvt_pk_fp8_f32(a, b, 0, false); p = __builtin_amdgcn_cvt_pk_fp8_f32(c, d, p, true); return (unsigned)p; }
__device__ __forceinline__ float silu_f(float x) { return x * __builtin_amdgcn_rcpf(1.0f + __expf(-x)); }
__device__ __forceinline__ float sigmoid_f(float x) { return __builtin_amdgcn_rcpf(1.0f + __expf(-x)); }

namespace pg8 {
constexpr int BM = 256, BK = 64, HALF = 128, HTB = HALF * BK * 2, STAGE_BYTES = 8 * HTB, NXCD = 8, WGM = 8;
__host__ __device__ __forceinline__ int lds_byte(int r, int c) { const int st = (r >> 4) * 2 + (c >> 5), rr = r & 15, cc = c & 31, ob = rr * 64 + cc * 2; return st * 1024 + (ob ^ (((ob >> 9) & 1) << 5)); }
__host__ __device__ __forceinline__ void stage_rc(int b, int& R, int& C) { const int st = b / 1024, sb = b % 1024, swz = sb ^ (((sb >> 9) & 1) << 5); R = (st >> 1) * 16 + swz / 64; C = (st & 1) * 32 + (swz % 64) / 2; }
__host__ __device__ __forceinline__ int perm32(int rho) { const int n = rho >> 4, i = rho & 15; return 8 * (i >> 2) + 4 * n + (i & 3); }

struct Unit { int pm, pn, aux; };
struct Gemm { const void* A; const void* Bt; int RB; };

struct StaticOrder {
    int nM, nN, nwg, G, c;
    __device__ void init(int M, int N, int G_, int c_) { nM = M / BM; nN = N / BM; nwg = nM * nN; G = G_; c = c_; }
    __device__ bool next(int i, Unit& u) const {
        const long L = (long)i * G + c; if (L >= nwg) return false;
        int wgid = (int)L; { const int q = nwg / NXCD, r = nwg % NXCD, xcd = wgid % NXCD, off = wgid / NXCD; wgid = (xcd < r ? xcd * (q + 1) : r * (q + 1) + (xcd - r) * q) + off; }
        const int nig = WGM * nN, gid = wgid / nig, fm = gid * WGM, gsz = (nM - fm) < WGM ? (nM - fm) : WGM;
        u.pm = fm + ((wgid % nig) % gsz); u.pn = (wgid % nig) / gsz; u.aux = i; return true;
    }
    __device__ __forceinline__ unsigned row_off(const Unit&, int) const { return 0u; }
};

template <class Epi, class Sched, bool ALIGN_EPI, bool GATHER, bool FP8 = false>
__device__ __forceinline__ void gemm_phase(LAS unsigned char* lds, const Gemm g, const Sched& S, const Epi& E) {
    int tid_ = threadIdx.x; asm volatile("" : "+v"(tid_));
    const int tid = tid_, wid = __builtin_amdgcn_readfirstlane(tid >> 6), lane = tid & 63, wr = wid >> 2, wc = wid & 3, fr = lane & 15, fq = lane >> 4;
    const int RB = g.RB; int nt_ = RB / (BK * 2); asm volatile("" : "+s"(nt_)); const int nt = nt_;
    unsigned voffB[2];
#pragma unroll
    for (int i = 0; i < 2; ++i) { int R, C; stage_rc(tid * 16 + i * 8192, R, C); const int Rb = Epi::PERM ? ((R & ~31) + perm32(R & 31)) : R;
        voffB[i] = (unsigned)(Rb * RB + C * 2); }
    const size_t kstep = (size_t)(BK * 2);
    const size_t hstep = (size_t)HALF * RB;
    const size_t ahs = GATHER ? (size_t)0 : hstep;
    const size_t tstep = 2 * hstep;
    const unsigned ldsw = (unsigned)wid * 1024u;
    const int aoff = lds_byte(wr * 64 + fr, fq * 8), boff = lds_byte(wc * 32 + fr, fq * 8);
#define PG8_SA(b, h) (((b) * 2 + (h)) * HTB)
#define PG8_SB(b, h) ((4 + (b) * 2 + (h)) * HTB)
#define PG8_STAGE(bufoff, gbase, voff) do { _Pragma("unroll") for (int _i = 0; _i < 2; ++_i) \
        __builtin_amdgcn_global_load_lds((const unsigned*)((const char*)(gbase) + (voff)[_i]), (LAS unsigned*)(lds + (bufoff) + ldsw + _i * 8192), 16, 0, 0); } while (0)
#define PG8_LDA(dst, b, h) do { if constexpr (FP8) { _Pragma("unroll") for (int m = 0; m < 4; ++m) { const i32x4 _lo = *(const LAS i32x4*)(lds + PG8_SA(b, h) + aoff + m * 2048), _hi = *(const LAS i32x4*)(lds + PG8_SA(b, h) + aoff + m * 2048 + 1024); \
            dst##8[m] = __builtin_shufflevector(_lo, _hi, 0, 1, 2, 3, 4, 5, 6, 7); } } \
        else { _Pragma("unroll") for (int m = 0; m < 4; ++m) _Pragma("unroll") for (int k = 0; k < 2; ++k) dst[m][k] = *(const LAS bf16x8*)(lds + PG8_SA(b, h) + aoff + m * 2048 + k * 1024); } } while (0)
#define PG8_LDB(dst, b, h) do { if constexpr (FP8) { _Pragma("unroll") for (int n = 0; n < 2; ++n) { const i32x4 _lo = *(const LAS i32x4*)(lds + PG8_SB(b, h) + boff + n * 2048), _hi = *(const LAS i32x4*)(lds + PG8_SB(b, h) + boff + n * 2048 + 1024); \
            dst##8[n] = __builtin_shufflevector(_lo, _hi, 0, 1, 2, 3, 4, 5, 6, 7); } } \
        else { _Pragma("unroll") for (int n = 0; n < 2; ++n) _Pragma("unroll") for (int k = 0; k < 2; ++k) dst[n][k] = *(const LAS bf16x8*)(lds + PG8_SB(b, h) + boff + n * 2048 + k * 1024); } } while (0)
#define PG8_MMA(ai, bj, At, Bt) do { __builtin_amdgcn_s_setprio(1); _Pragma("unroll") for (int m = 0; m < 4; ++m) _Pragma("unroll") for (int n = 0; n < 2; ++n) { \
        if constexpr (FP8) asm volatile("v_mfma_scale_f32_16x16x128_f8f6f4 %0, %1, %2, %0, %3, %3 op_sel_hi:[0,0,0]" : "+v"(acc[ai][bj][m][n]) : "v"(Bt##8[n]), "v"(At##8[m]), "v"(scl1));   \
        else { _Pragma("unroll") for (int k = 0; k < 2; ++k) acc[ai][bj][m][n] = __builtin_amdgcn_mfma_f32_16x16x32_bf16(Bt[n][k], At[m][k], acc[ai][bj][m][n], 0, 0, 0); } } \
        __builtin_amdgcn_s_setprio(0); } while (0)
#define PG8_WAIT_V(n) asm volatile("s_waitcnt vmcnt(" #n ")" ::: "memory")
#define PG8_WAIT_L(n) asm volatile("s_waitcnt lgkmcnt(" #n ")" ::: "memory")
#define PG8_BAR __builtin_amdgcn_s_barrier()
#define PG8_SCHED __builtin_amdgcn_sched_barrier(0)
#define PG8_SETVA(v, u) do { _Pragma("unroll") for (int _i = 0; _i < 2; ++_i) { int _R, _C; stage_rc(tid * 16 + _i * 8192, _R, _C); \
        if constexpr (GATHER) { v[0][_i] = S.row_off(u, _R) + (unsigned)_C * 2u; v[1][_i] = S.row_off(u, HALF + _R) + (unsigned)_C * 2u; } \
        else { v[0][_i] = (unsigned)(_R * RB + _C * 2); v[1][_i] = v[0][_i]; } } } while (0)
    Unit cur, nxt; int ui = 0;
    if (!S.next(0, cur)) return;
    f32x4 acc[2][2][4][2];
#pragma unroll
    for (int a = 0; a < 2; ++a)
#pragma unroll
        for (int b = 0; b < 2; ++b)
#pragma unroll
            for (int m = 0; m < 4; ++m)
#pragma unroll
                for (int n = 0; n < 2; ++n) acc[a][b][m][n] = (f32x4){0.f, 0.f, 0.f, 0.f};
    const int scl1 = 0x7f7f7f7f;
    bf16x8 At[4][2], B0[2][2], B1[2][2]; i32x8 At8[4], B08[2], B18[2];
    unsigned vA[2][2], vAn[2][2];
    PG8_SETVA(vA, cur);
    const char* cA = GATHER ? (const char*)g.A : (const char*)g.A + (size_t)cur.pm * tstep; const char* cB = (const char*)g.Bt + (size_t)cur.pn * tstep;
    PG8_STAGE(PG8_SB(0, 0), cB, voffB); PG8_STAGE(PG8_SB(0, 1), cB + hstep, voffB); PG8_STAGE(PG8_SA(0, 0), cA, vA[0]); PG8_STAGE(PG8_SA(0, 1), cA + ahs, vA[1]);
    if (wr == 1) PG8_BAR;
    PG8_WAIT_V(2); PG8_BAR;
    PG8_STAGE(PG8_SB(1, 0), cB + kstep, voffB); PG8_STAGE(PG8_SA(1, 0), cA + kstep, vA[0]); PG8_STAGE(PG8_SB(1, 1), cB + hstep + kstep, voffB);
    PG8_WAIT_V(6); PG8_BAR;
    for (;;) {
        const bool has_next = S.next(ui + 1, nxt);
        const char* nA = GATHER ? cA : (has_next ? (const char*)g.A + (size_t)nxt.pm * tstep : cA);
        const char* nB = has_next ? (const char*)g.Bt + (size_t)nxt.pn * tstep : cB;
        if constexpr (GATHER) {
            if (has_next) { PG8_SETVA(vAn, nxt); }
            else {
#pragma unroll
                for (int h = 0; h < 2; ++h)
#pragma unroll
                    for (int i = 0; i < 2; ++i) vAn[h][i] = vA[h][i]; }
        }
#pragma unroll 1
        for (int t = 0; t < nt; t += 2) {
            const bool last = (t == nt - 2);
            const char* a1 = cA + (size_t)(t + 1) * kstep;
            const char* a2 = last ? nA : cA + (size_t)(t + 2) * kstep; const char* b2 = last ? nB : cB + (size_t)(t + 2) * kstep;
            const char* a3 = a2 + kstep; const char* b3 = b2 + kstep;
            unsigned v2[2][2];
#pragma unroll
            for (int h = 0; h < 2; ++h)
#pragma unroll
                for (int i = 0; i < 2; ++i) { if constexpr (GATHER) v2[h][i] = last ? vAn[h][i] : vA[h][i]; else v2[h][i] = vA[h][i]; }
            PG8_LDB(B0, 0, 0); PG8_LDB(B1, 0, 1); PG8_SCHED; PG8_LDA(At, 0, 0); PG8_STAGE(PG8_SA(1, 1), a1 + ahs, vA[1]);
            PG8_WAIT_V(8); PG8_WAIT_L(0); PG8_BAR; PG8_MMA(0, 0, At, B0); PG8_MMA(0, 1, At, B1); PG8_BAR; PG8_SCHED;
            PG8_LDA(At, 0, 1); PG8_STAGE(PG8_SB(0, 0), b2, voffB); PG8_STAGE(PG8_SB(0, 1), b2 + hstep, voffB); PG8_STAGE(PG8_SA(0, 0), a2, v2[0]);
            PG8_WAIT_V(8); PG8_WAIT_L(0); PG8_BAR; PG8_MMA(1, 0, At, B0); PG8_MMA(1, 1, At, B1); PG8_BAR; PG8_SCHED;
            PG8_LDB(B0, 1, 0); PG8_LDB(B1, 1, 1); PG8_SCHED; PG8_LDA(At, 1, 0); PG8_STAGE(PG8_SA(0, 1), a2 + ahs, v2[1]);
            PG8_WAIT_V(8); PG8_WAIT_L(0); PG8_BAR; PG8_MMA(0, 0, At, B0); PG8_MMA(0, 1, At, B1); PG8_BAR; PG8_SCHED;
            PG8_LDA(At, 1, 1); PG8_STAGE(PG8_SB(1, 0), b3, voffB); PG8_STAGE(PG8_SB(1, 1), b3 + hstep, voffB); PG8_STAGE(PG8_SA(1, 0), a3, v2[0]);
            PG8_WAIT_V(8); PG8_WAIT_L(0); PG8_BAR; PG8_MMA(1, 0, At, B0); PG8_MMA(1, 1, At, B1); PG8_BAR; PG8_SCHED;
        }
        if constexpr (ALIGN_EPI) { if (wr == 0) PG8_BAR; }
        if constexpr (FP8) asm volatile("s_nop 15\n\ts_nop 15" ::: "memory");
        E(acc, cur, wr, wc, fr, fq);
        if (!has_next) break;
#pragma unroll
        for (int a = 0; a < 2; ++a)
#pragma unroll
            for (int b = 0; b < 2; ++b)
#pragma unroll
                for (int m = 0; m < 4; ++m)
#pragma unroll
                    for (int n = 0; n < 2; ++n) acc[a][b][m][n] = (f32x4){0.f, 0.f, 0.f, 0.f};
        cur = nxt; cA = nA; cB = nB; ++ui;
        if constexpr (GATHER) {
#pragma unroll
            for (int h = 0; h < 2; ++h)
#pragma unroll
                for (int i = 0; i < 2; ++i) vA[h][i] = vAn[h][i]; }
        if constexpr (ALIGN_EPI) { if (wr == 1) PG8_BAR; }
    }
    PG8_WAIT_V(0);
    if constexpr (!ALIGN_EPI) { if (wr == 0) PG8_BAR; }
    PG8_BAR;
#undef PG8_SA
#undef PG8_SB
#undef PG8_STAGE
#undef PG8_LDA
#undef PG8_LDB
#undef PG8_MMA
#undef PG8_WAIT_V
#undef PG8_WAIT_L
#undef PG8_BAR
#undef PG8_SCHED
#undef PG8_SETVA
}
}

#define XB_TMO      128
#define XB_XCNT(j)  (256  + 64 * (j))
#define XB_XSUB(j)  (1280 + 64 * (j))
#define XB_XGEN(j)  (2304 + 64 * (j))
#define XB_TOP      3328
#define XB_TOPGEN   3392
#define XCD_BAR_WORDS 3456
#define XB_SPIN_CAP (1u << 18)
__device__ __forceinline__ unsigned xb_ld(unsigned* p)              { return __hip_atomic_load(p, __ATOMIC_RELAXED, __HIP_MEMORY_SCOPE_AGENT); }
__device__ __forceinline__ unsigned xb_add(unsigned* p, unsigned v) { return __hip_atomic_fetch_add(p, v, __ATOMIC_RELAXED, __HIP_MEMORY_SCOPE_AGENT); }
__device__ __forceinline__ unsigned xb_xcc_id() { return (unsigned)__builtin_amdgcn_s_getreg((3 << 11) | 20) & 0xFu; }
#define XB_SPIN(cond, bar) do { unsigned _sp = 0; while (cond) { __builtin_amdgcn_s_sleep(1); \
    if ((++_sp & 255u) == 0u) { if (xb_ld(&(bar)[XB_TMO])) break; if (_sp > XB_SPIN_CAP) { atomicAdd(&(bar)[XB_TMO], 1u); break; } } } } while (0)
struct XcdBarrier { unsigned* bar; unsigned x; volatile LAS unsigned* st; };
__device__ __forceinline__ XcdBarrier xcd_barrier_post(unsigned* bar, volatile LAS unsigned* st) {
    XcdBarrier b; b.bar = bar; b.x = xb_xcc_id(); b.st = st;
    if (threadIdx.x == 0) (void)xb_add(&bar[XB_XCNT(b.x)], 1u);
    return b;
}
__device__ __forceinline__ void xcd_barrier_complete(unsigned* bar, unsigned x, unsigned& nloc, unsigned& nx) {
    const unsigned G = gridDim.x * gridDim.y * gridDim.z;
    unsigned sum, cnt, mine, sp = 0u;
    for (;;) {
        sum = 0u; cnt = 0u; mine = 0u;
#pragma unroll
        for (unsigned j = 0; j < 16; ++j) { const unsigned c = xb_ld(&bar[XB_XCNT(j)]); sum += c; cnt += (c > 0u) ? 1u : 0u; mine = (j == x) ? c : mine; }
        if (sum == G) break;
        __builtin_amdgcn_s_sleep(1);
        if ((++sp & 255u) == 0u) { if (xb_ld(&bar[XB_TMO])) break; if (sp > XB_SPIN_CAP) { atomicAdd(&bar[XB_TMO], 1u); break; } }
    }
    nloc = mine > 0u ? mine : 1u; nx = cnt > 0u ? cnt : 1u;
}
__device__ __forceinline__ void xcd_barrier(const XcdBarrier& b) {
    asm volatile("s_waitcnt vmcnt(0)" ::: "memory");
    __syncthreads();
    if (threadIdx.x == 0) {
        unsigned* bar = b.bar;
        __builtin_amdgcn_s_waitcnt(0);
        unsigned nloc = b.st[0], nx = b.st[1];
        if (nloc == 0u) { xcd_barrier_complete(bar, b.x, nloc, nx); b.st[0] = nloc; b.st[1] = nx; }
        const unsigned old = xb_add(&bar[XB_XSUB(b.x)], 1u);
        const unsigned gen = old / nloc;
        if (old + 1u == (gen + 1u) * nloc) {
            __builtin_amdgcn_fence(__ATOMIC_RELEASE, "agent");
            asm volatile("s_waitcnt vmcnt(0)" ::: "memory");
            const unsigned og = xb_add(&bar[XB_TOP], 1u);
            const unsigned tg = og / nx;
            if (og + 1u == (tg + 1u) * nx) xb_add(&bar[XB_TOPGEN], 1u);
            else XB_SPIN(xb_ld(&bar[XB_TOPGEN]) == tg, bar);
            __builtin_amdgcn_fence(__ATOMIC_ACQUIRE, "agent");
            xb_add(&bar[XB_XGEN(b.x)], 1u);
            asm volatile("s_waitcnt vmcnt(0)" ::: "memory");
        } else {
            XB_SPIN(xb_ld(&bar[XB_XGEN(b.x)]) == gen, bar);
            __builtin_amdgcn_fence(__ATOMIC_ACQUIRE, "agent");
            asm volatile("s_waitcnt vmcnt(0)" ::: "memory");
        }
    }
    __syncthreads();
}
__device__ __forceinline__ void xcd_arrive(const XcdBarrier& b, unsigned* slot) {
    asm volatile("s_waitcnt vmcnt(0)" ::: "memory");
    __syncthreads();
    if (threadIdx.x == 0) {
        __builtin_amdgcn_s_waitcnt(0);
        const unsigned nloc = b.st[0];
        const unsigned old = xb_add(&slot[64 * b.x], 1u);
        if (old + 1u == nloc) {
            __builtin_amdgcn_fence(__ATOMIC_RELEASE, "agent");
            asm volatile("s_waitcnt vmcnt(0)" ::: "memory");
            xb_add(&slot[1024], 1u);
        }
    }
}
__device__ __forceinline__ void xcd_wait(const XcdBarrier& b, unsigned* slot) {
    if (threadIdx.x == 0) {
        const unsigned nx = b.st[1];
        XB_SPIN(xb_ld(&slot[1024]) < nx, b.bar);
        __builtin_amdgcn_fence(__ATOMIC_ACQUIRE, "agent");
        asm volatile("s_waitcnt vmcnt(0)" ::: "memory");
    }
    __syncthreads();
}

struct Frame {
    LAS unsigned char* lds;
    int tid, lane, wave, G, bid;
    float* out;
    unsigned char* ws;
};
__device__ __forceinline__ const float* inptr(const Frame& F, int k) {
    const LAS unsigned* t = (const LAS unsigned*)(F.lds + LDS_PTR) + 2 * k;
    const unsigned lo = __builtin_amdgcn_readfirstlane(t[0]), hi = __builtin_amdgcn_readfirstlane(t[1]);
    return (const float*)(const GAS float*)(((unsigned long long)hi << 32) | lo);
}
#define WSP(T, off) ((T*)(F.ws + (off)))
#define F_CTL WSP(unsigned, WS_CTL)
#define F_MOD WSP(float, WS_MOD)
#define F_ROPE WSP(float, WS_ROPE)
#define F_DECAY WSP(float, WS_DECAY)
#define F_WIN WSP(fp8, WS_WIN)
#define F_WOUT WSP(fp8, WS_WOUT)
#define F_WGU WSP(fp8, WS_WGU)
#define F_WD WSP(fp8, WS_WD)
#define F_HX WSP(bf16, WS_HX)
#define F_PX WSP(bf16, WS_PX)
#define F_ACT WSP(fp8, WS_PX)
#define F_HX8 WSP(fp8, WS_HX)
#define F_MIX WSP(fp8, WS_MIX)
#define F_YBUF WSP(fp8, WS_MIX)
#define F_PV WSP(float, WS_PV)
#define F_GST WSP(bf16, WS_GST)
#define F_XB WSP(bf16, WS_XB)
#define F_RWH WSP(bf16, WS_RWP)
#define F_RWL WSP(bf16, WS_RWP + 1 * MiB)
#define F_CB WSP(float, WS_RWP + 2 * MiB)
#define F_KNL WSP(bf16, WS_RWP + 8 * MiB)
#define F_VNL WSP(bf16, WS_RWP + 32 * MiB)
#define F_KNC WSP(bf16, WS_GST + 41 * MiB)
#define F_VNC WSP(bf16, WS_GST + 44 * MiB)
#define F_AF WSP(float, WS_RWP + 3 * MiB)
#define F_BF WSP(float, WS_RWP + 4 * MiB)
#define F_LIST WSP(int, WS_LIST)
#define F_SLOTW WSP(float, WS_LIST + 2 * MiB + 512 * 1024)
#define F_SPOS WSP(int, WS_XC)

struct EpiPx {
    static constexpr bool PERM = true;
    bf16* O; unsigned char* ws;
    __device__ __forceinline__ void operator()(const f32x4 (&acc)[2][2][4][2], const pg8::Unit& u, int wr, int wc, int fr, int fq) const {
        const int t0 = u.pm * 256, row0 = t0 + wr * 64 + fr, col0 = u.pn * 256 + wc * 32 + 8 * fq;
        const bool lat = t0 < ML; const int b = lat ? (t0 >> 11) : ((t0 - ML) >> 8); const int tb = lat ? b * 2048 : ML + b * 256;
#pragma unroll
        for (int bj = 0; bj < 2; ++bj) {
            const int cw = u.pn * 256 + bj * 128 + wc * 32;
            bf16* base; size_t rstride;
            if (cw >= C_NK && cw < C_CV) { const bool isv = cw >= C_NV; const int cc = cw - (isv ? C_NV : C_NK), h = cc >> 6, d0 = (cc & 63) + 8 * fq;
                const size_t off = lat ? (isv ? WS_RWP + 32 * MiB : WS_RWP + 8 * MiB) : (isv ? WS_GST + 44 * MiB : WS_GST + 41 * MiB);
                base = (bf16*)(ws + off) + (size_t)(b * 6 + h) * (lat ? 2048 * 64 : 256 * 64) + (size_t)(row0 - tb) * 64 + d0; rstride = 64; }
            else { base = O + (size_t)row0 * NPX + col0 + bj * 128; rstride = NPX; }
#pragma unroll
            for (int ai = 0; ai < 2; ++ai)
#pragma unroll
                for (int m = 0; m < 4; ++m) { const f32x4 v0 = acc[ai][bj][m][0] * 0.015625f, v1 = acc[ai][bj][m][1] * 0.015625f;
                    u32x4 w; w.x = cvt_pk_bf16(v0[0], v0[1]); w.y = cvt_pk_bf16(v0[2], v0[3]); w.z = cvt_pk_bf16(v1[0], v1[1]); w.w = cvt_pk_bf16(v1[2], v1[3]);
                    *(u32x4*)(base + (size_t)(ai * 128 + m * 16) * rstride) = w; }
        }
    }
};
template <bool L0>
struct EpiResid {
    static constexpr bool PERM = true;
    const float* lat_in; const float* ctx_in; bf16* xb; const float* modl;
    __device__ __forceinline__ void operator()(const f32x4 (&acc)[2][2][4][2], const pg8::Unit& u, int wr, int wc, int fr, int fq) const {
        const int t0 = u.pm * 256; const bool lat = t0 < ML; const int b = lat ? (t0 >> 11) : 16;
        const float* base = lat ? lat_in + (size_t)t0 * D : ctx_in + (size_t)(t0 - ML) * D;
        const int col0 = u.pn * 256 + wc * 32 + 8 * fq;
        const float* gate = modl + (size_t)b * 6144 + 2 * 1024 + col0;
        f32x4 gv[2][2];
#pragma unroll
        for (int bj = 0; bj < 2; ++bj)
#pragma unroll
            for (int n = 0; n < 2; ++n) gv[bj][n] = *(const f32x4*)(gate + bj * 128 + 4 * n);
#pragma unroll
        for (int ai = 0; ai < 2; ++ai)
#pragma unroll
            for (int m = 0; m < 4; ++m) { const int rr = ai * 128 + wr * 64 + m * 16 + fr; bf16* op = xb + (size_t)(t0 + rr) * D + col0;
#pragma unroll
                for (int bj = 0; bj < 2; ++bj) { f32x4 b0, b1;
                    if constexpr (L0) { b0 = *(const f32x4*)(base + (size_t)rr * D + col0 + bj * 128); b1 = *(const f32x4*)(base + (size_t)rr * D + col0 + bj * 128 + 4); }
                    else { const u32x4 w = *(const u32x4*)(op + bj * 128); b0 = (f32x4){bflo(w.x), bfhi(w.x), bflo(w.y), bfhi(w.y)}; b1 = (f32x4){bflo(w.z), bfhi(w.z), bflo(w.w), bfhi(w.w)}; }
                    const f32x4 v0 = b0 + gv[bj][0] * (acc[ai][bj][m][0] * 0.015625f), v1 = b1 + gv[bj][1] * (acc[ai][bj][m][1] * 0.015625f);
                    u32x4 o; o.x = cvt_pk_bf16(v0[0], v0[1]); o.y = cvt_pk_bf16(v0[2], v0[3]); o.z = cvt_pk_bf16(v1[0], v1[1]); o.w = cvt_pk_bf16(v1[2], v1[3]);
                    *(u32x4*)(op + bj * 128) = o; } }
    }
};
struct EpiSwiGLU {
    static constexpr bool PERM = true;
    fp8* act;
    __device__ __forceinline__ void operator()(const f32x4 (&acc)[2][2][4][2], const pg8::Unit& u, int wr, int wc, int fr, int fq) const {
        const int row0 = u.pm * 256 + wr * 64 + fr, col0 = (u.pn & 7) * 128 + wc * 32 + 8 * fq;
#pragma unroll
        for (int ai = 0; ai < 2; ++ai)
#pragma unroll
            for (int m = 0; m < 4; ++m) { fp8* rowp = act + (size_t)(row0 + ai * 128 + m * 16) * 1024 + col0;
                f32x4 r4[2];
#pragma unroll
                for (int n = 0; n < 2; ++n) { const f32x4 ag = acc[ai][0][m][n], au = acc[ai][1][m][n]; const f32x4 t = ag * (-1.4426950408889634f * 0.015625f);
                    f32x4 e; e[0] = __builtin_amdgcn_exp2f(t[0]); e[1] = __builtin_amdgcn_exp2f(t[1]); e[2] = __builtin_amdgcn_exp2f(t[2]); e[3] = __builtin_amdgcn_exp2f(t[3]);
                    const f32x4 d = e + 1.0f;
                    f32x4 rc; rc[0] = __builtin_amdgcn_rcpf(d[0]); rc[1] = __builtin_amdgcn_rcpf(d[1]); rc[2] = __builtin_amdgcn_rcpf(d[2]); rc[3] = __builtin_amdgcn_rcpf(d[3]);
                    r4[n] = (ag * au) * (rc * 0.000244140625f); }
                u32x2 w; w.x = pk4_fp8(r4[0][0], r4[0][1], r4[0][2], r4[0][3]); w.y = pk4_fp8(r4[1][0], r4[1][1], r4[1][2], r4[1][3]);
                *(u32x2*)rowp = w; }
    }
};
struct EpiYrow {
    static constexpr bool PERM = true;
    fp8* yrow;
    __device__ __forceinline__ void operator()(const f32x4 (&acc)[2][2][4][2], const pg8::Unit& u, int wr, int wc, int fr, int fq) const {
        const int row0 = u.pm * 256 + wr * 64 + fr, col0 = (u.pn & 3) * 256 + wc * 32 + 8 * fq;
#pragma unroll
        for (int ai = 0; ai < 2; ++ai)
#pragma unroll
            for (int m = 0; m < 4; ++m) { fp8* rowp = yrow + (size_t)(row0 + ai * 128 + m * 16) * 1024 + col0;
#pragma unroll
                for (int bj = 0; bj < 2; ++bj) { const f32x4 v0 = acc[ai][bj][m][0] * 0.25f, v1 = acc[ai][bj][m][1] * 0.25f;
                    u32x2 w; w.x = pk4_fp8(v0[0], v0[1], v0[2], v0[3]); w.y = pk4_fp8(v1[0], v1[1], v1[2], v1[3]);
                    *(u32x2*)(rowp + bj * 128) = w; } }
    }
};

struct SplitOrder {
    pg8::StaticOrder base; int i0, i1;
    __device__ __forceinline__ bool next(int i, pg8::Unit& u) const { return (i0 + i < i1) && base.next(i0 + i, u); }
    __device__ __forceinline__ unsigned row_off(const pg8::Unit&, int) const { return 0u; }
};
struct MoeOrder {
    const LAS int* mbase; const LAS int* rows; int NT, G, c, TM; unsigned rowbytes;
    __device__ __forceinline__ bool next(int i, pg8::Unit& u) const {
        int pnl, gm;
        if ((G & 7) == 0) { const int xcd = c & 7, j = c >> 3, q = i * (G >> 3) + j; pnl = q % NT; gm = (q / NT) * 8 + xcd; }
        else { const int L = i * G + c; pnl = L % NT; gm = L / NT; }
        if (gm >= TM) return false;
        int e = 0;
#pragma unroll
        for (int k = 1; k < 16; ++k) e += (mbase[k] <= gm) ? 1 : 0;
        u.pm = gm; u.pn = __builtin_amdgcn_readfirstlane(e) * NT + pnl; u.aux = i; return true;
    }
    __device__ __forceinline__ unsigned row_off(const pg8::Unit& u, int r) const { const int s = rows[u.aux * 256 + r]; return s < 0 ? 0u : (unsigned)(s >> 1) * rowbytes; }
};

__device__ __forceinline__ void transpose_item(const float* W, int ldw, int k0, int n0, bf16* WT, int Kd, int drow0, LAS float* scr, int lane) {
#pragma unroll 8
    for (int i = 0; i < 32; ++i) { const int kk = 2 * i + (lane >> 5); scr[kk * 33 + (lane & 31)] = W[(size_t)(k0 + kk) * ldw + n0 + (lane & 31)]; }
    asm volatile("s_waitcnt lgkmcnt(0)" ::: "memory");
    const int c = lane & 7;
#pragma unroll
    for (int j = 0; j < 4; ++j) { const int n = (lane >> 3) + 8 * j; const LAS float* s = scr + (8 * c) * 33 + n;
        u32x4 o; o.x = cvt_pk_bf16(s[0 * 33], s[1 * 33]); o.y = cvt_pk_bf16(s[2 * 33], s[3 * 33]); o.z = cvt_pk_bf16(s[4 * 33], s[5 * 33]); o.w = cvt_pk_bf16(s[6 * 33], s[7 * 33]);
        *(u32x4*)(WT + (size_t)(drow0 + n) * Kd + k0 + 8 * c) = o; }
    asm volatile("s_waitcnt lgkmcnt(0)" ::: "memory");
}
__device__ __forceinline__ void transpose_item_fp8(const float* W, int ldw, int k0, int n0, fp8* WT, int Kd, int drow0, LAS float* scr, int lane) {
    float wv[32];
#pragma unroll
    for (int i = 0; i < 32; ++i) { const int kk = 2 * i + (lane >> 5); wv[i] = W[(size_t)(k0 + kk) * ldw + n0 + (lane & 31)]; }
#pragma unroll
    for (int i = 0; i < 32; ++i) { const int kk = 2 * i + (lane >> 5); scr[kk * 33 + (lane & 31)] = wv[i] * 64.0f; }
    asm volatile("s_waitcnt lgkmcnt(0)" ::: "memory");
    const int c = lane & 3;
#pragma unroll
    for (int j = 0; j < 2; ++j) { const int n = (lane >> 2) + 16 * j; const LAS float* s = scr + (16 * c) * 33 + n;
        u32x4 o; o.x = pk4_fp8(s[0 * 33], s[1 * 33], s[2 * 33], s[3 * 33]); o.y = pk4_fp8(s[4 * 33], s[5 * 33], s[6 * 33], s[7 * 33]);
        o.z = pk4_fp8(s[8 * 33], s[9 * 33], s[10 * 33], s[11 * 33]); o.w = pk4_fp8(s[12 * 33], s[13 * 33], s[14 * 33], s[15 * 33]);
        *(u32x4*)(WT + (size_t)(drow0 + n) * Kd + k0 + 16 * c) = o; }
    asm volatile("s_waitcnt lgkmcnt(0)" ::: "memory");
}
__device__ __forceinline__ void moe_convert(const Frame& F, int l, int first, int stride) {
    LAS float* T = (LAS float*)F.lds;
    const int tid = F.tid;
    constexpr int NIT = NE * 3 * 32;
    f32x4 v[16];
#define MC_LOAD(it0) do { const int _it = l * NIT + (it0); const int _le = _it / 96, _q = _it % 96, _which = _q / 32, _kb = (_q % 32) >> 2, _nb = _q & 3; \
        const float* _W = inptr(F, _which == 0 ? 22 : (_which == 1 ? 23 : 24)) + (size_t)_le * D * D + (size_t)(128 * _kb) * D + 256 * _nb; \
        _Pragma("unroll") for (int i = 0; i < 16; ++i) { const int idx = tid + 512 * i, kk = idx >> 6, c4 = idx & 63; v[i] = *(const f32x4*)(_W + (size_t)kk * D + 4 * c4); } } while (0)
    if (first < NIT) MC_LOAD(first);
    for (int it0 = first; it0 < NIT; it0 += stride) {
        const int it = l * NIT + it0;
        const int le = it / 96, q = it % 96, which = q / 32, kb = (q % 32) >> 2, nb = q & 3, k0 = 128 * kb, n0 = 256 * nb;
#pragma unroll
        for (int i = 0; i < 16; ++i) { const int idx = tid + 512 * i, kk = idx >> 6, c4 = idx & 63; *(LAS f32x4*)(T + kk * 260 + 4 * c4) = v[i] * 64.0f; }
        if (it0 + stride < NIT) MC_LOAD(it0 + stride);
        __syncthreads();
        fp8* WT = (which == 2) ? F_WD + (size_t)le * D * D : F_WGU + (size_t)le * 2048 * D;
#pragma unroll
        for (int i = 0; i < 4; ++i) { const int idx = tid + 512 * i, n = idx & 255, c = idx >> 8;
            const LAS float* s = T + (16 * c) * 260 + n;
            u32x4 o; o.x = pk4_fp8(s[0 * 260], s[1 * 260], s[2 * 260], s[3 * 260]); o.y = pk4_fp8(s[4 * 260], s[5 * 260], s[6 * 260], s[7 * 260]);
            o.z = pk4_fp8(s[8 * 260], s[9 * 260], s[10 * 260], s[11 * 260]); o.w = pk4_fp8(s[12 * 260], s[13 * 260], s[14 * 260], s[15 * 260]);
            const int nn = n0 + n; const int drow = (which == 2) ? nn : ((nn >> 7) * 256 + (which == 1 ? 128 : 0) + (nn & 127));
            *(u32x4*)(WT + (size_t)drow * D + k0 + 16 * c) = o; }
        __syncthreads();
    }
#undef MC_LOAD
}
__device__ __forceinline__ void phase_prologue(const Frame& F) {
    const int gw = F.bid * 8 + F.wave, NGW = F.G * 8, lane = F.lane;
    auto part_a = [&]() {
        LAS float* scr = (LAS float*)(F.lds + F.wave * 16384);
        constexpr int I_IN = 16 * 89, I_OUT = 512, I_E = 512;
        constexpr int N_IN = DEPTH * I_IN, N_OUT = DEPTH * I_OUT, N_MOE = DEPTH * NE * 3 * I_E;
        for (int it = gw; it < N_IN + N_OUT; it += NGW) {
            int r = it;
            if (r < N_IN) { const int l = r / I_IN, q = r % I_IN, kb = q / 89, nb = q % 89;
                transpose_item_fp8(inptr(F, 8) + (size_t)l * D * NIN, NIN, 64 * kb, 32 * nb, F_WIN + (size_t)l * NPX * D, D, 32 * nb, scr, lane); continue; }
            r -= N_IN;
            if (r < N_OUT) { const int l = r / I_OUT, q = r % I_OUT, kb = q / 32, nb = q % 32;
                transpose_item_fp8(inptr(F, 19) + (size_t)l * D * D, D, 64 * kb, 32 * nb, F_WOUT + (size_t)l * D * D, D, 32 * nb, scr, lane); continue; }
        }
        for (int i = F.bid * 512 + F.tid; i < DEPTH * (NPX - NIN) * (D / 16); i += F.G * 512) { const int l = i / ((NPX - NIN) * (D / 16)), q = i % ((NPX - NIN) * (D / 16));
            *(u32x4*)(F_WIN + (size_t)l * NPX * D + (size_t)NIN * D + (size_t)q * 16) = (u32x4){0u, 0u, 0u, 0u}; }
        __syncthreads();
    };
    auto part_c = [&]() {
    if (F.bid == 0) { for (int i = F.tid; i < 64 * 12; i += 512) { const int p = i / 12, j = i % 12; const float inv = powf(10000.0f, -(float)(2 * j) / 24.0f); float sn, cs; sincosf((float)p * inv, &sn, &cs); F_ROPE[2 * i] = cs; F_ROPE[2 * i + 1] = sn; } }
    {
        LAS float* sL = (LAS float*)F.lds;
        LAS float* red = (LAS float*)(F.lds + 17 * 1024 * 4);
        for (int i = F.tid; i < 17 * 1024; i += 512) { const int r = i >> 10, k = i & 1023; const float v = r < 16 ? inptr(F, 1)[r * 1024 + k] : inptr(F, 3)[k]; sL[i] = v / (1.0f + expf(-v)); }
        __syncthreads();
        for (int u = F.bid; u < DEPTH * 96; u += F.G) {
            const int l = u / 96, n0 = (u % 96) * 64;
            const float* W = inptr(F, 4) + (size_t)l * D * 6144 + n0 + lane;
            float acc[17];
#pragma unroll
            for (int r = 0; r < 17; ++r) acc[r] = 0.f;
            const int kb = F.wave * 128;
            for (int k0 = 0; k0 < 128; k0 += 32) { float wv[32];
#pragma unroll
                for (int k = 0; k < 32; ++k) wv[k] = W[(size_t)(kb + k0 + k) * 6144];
#pragma unroll
                for (int k = 0; k < 32; ++k)
#pragma unroll
                    for (int r = 0; r < 17; ++r) acc[r] += sL[r * 1024 + kb + k0 + k] * wv[k]; }
#pragma unroll
            for (int r = 0; r < 17; ++r) red[(F.wave * 17 + r) * 64 + lane] = acc[r];
            __syncthreads();
            for (int i = F.tid; i < 17 * 64; i += 512) { const int r = i >> 6, nn = i & 63; float s = inptr(F, 5)[l * 6144 + n0 + nn];
#pragma unroll
                for (int w = 0; w < 8; ++w) s += red[(w * 17 + r) * 64 + nn];
                F_MOD[((size_t)l * 17 + r) * 6144 + n0 + nn] = s; }
            __syncthreads();
        }
    }
    };
    if (F.bid & 1) { part_a(); part_c(); } else { part_c(); part_a(); }
}

__device__ __forceinline__ void moe_tilebase_to_lds(const Frame& F, int lm) {
    LAS int* tab = (LAS int*)(F.lds + LDS_MOE);
    if (F.tid < 16) tab[F.tid] = (int)__hip_atomic_load(F_CTL + CW_MOE + (lm * 16 + F.tid) * 64, __ATOMIC_RELAXED, __HIP_MEMORY_SCOPE_AGENT);
    __syncthreads();
    if (F.tid == 0) { int acc = 0;
#pragma unroll
        for (int e = 0; e < 16; ++e) { tab[16 + e] = acc; acc += (tab[e] + 255) >> 8; } }
    __syncthreads();
}
__device__ __forceinline__ int moe_slot_row(const Frame& F, int slot) { const int v = F_SPOS[slot]; return ((const LAS int*)(F.lds + LDS_MOE))[16 + (v >> 20)] * 256 + (v & 0xFFFFF); }
template <bool DRY = false>
__device__ __forceinline__ void phase_norm1(const Frame& F, int l) {
    const int gw = F.bid * 8 + F.wave, NGW = F.G * 8, lane = F.lane;
    const int per = (MT + NGW - 1) / NGW, mstart = gw * per, mend = (mstart + per < MT) ? mstart + per : MT;
    const float* gmix = inptr(F, 6) + l * 1024;
    f32x4 gm[4];
#pragma unroll
    for (int j = 0; j < 4; ++j) gm[j] = *(const f32x4*)(gmix + 4 * lane + 256 * j);
    f32x4 ga[4], shv[4], g5v[4];
    struct Row { f32x4 xf[4]; u32x2 xb[4]; unsigned y0[4], y1[4]; float w0, w1; };
    Row R0, R1, R2, R3;
#define N1_LOAD(R, m) do { const bool _lat = (m) < ML; \
        if (l == 0) { const float* _xin = _lat ? inptr(F, 0) + (size_t)(m) * D : inptr(F, 2) + (size_t)((m) - ML) * D; _Pragma("unroll") for (int j = 0; j < 4; ++j) R.xf[j] = *(const f32x4*)(_xin + 4 * lane + 256 * j); } \
        else { const bf16* _x = F_XB + (size_t)(m) * D; const int _i = (m) - mstart; const fp8* _y0 = F_YBUF + (size_t)__builtin_amdgcn_readlane(rowA, _i) * D; const fp8* _y1 = F_YBUF + (size_t)__builtin_amdgcn_readlane(rowB, _i) * D; \
            R.w0 = __int_as_float(__builtin_amdgcn_readlane(__float_as_int(wA), _i)); R.w1 = __int_as_float(__builtin_amdgcn_readlane(__float_as_int(wB), _i)); \
            _Pragma("unroll") for (int j = 0; j < 4; ++j) { R.xb[j] = *(const u32x2*)(_x + 4 * lane + 256 * j); R.y0[j] = *(const unsigned*)(_y0 + 4 * lane + 256 * j); R.y1[j] = *(const unsigned*)(_y1 + 4 * lane + 256 * j); } } asm volatile("" ::: "memory"); } while (0)
#define N1_DO(R, m) do { \
        f32x4 v[4]; \
        if (l == 0) { _Pragma("unroll") for (int j = 0; j < 4; ++j) v[j] = R.xf[j]; } \
        else { bf16* _xst = F_XB + (size_t)(m) * D; \
            _Pragma("unroll") for (int j = 0; j < 4; ++j) { v[j] = bf4(R.xb[j]) + g5v[j] * (fp84(R.y0[j]) * R.w0 + fp84(R.y1[j]) * R.w1); \
                if (!DRY) { u32x2 _xw; _xw.x = cvt_pk_bf16(v[j][0], v[j][1]); _xw.y = cvt_pk_bf16(v[j][2], v[j][3]); *(u32x2*)(_xst + 4 * lane + 256 * j) = _xw; } } } \
        f32x2 _s2 = {0.f, 0.f};     \
        _Pragma("unroll") for (int j = 0; j < 4; ++j) { _s2 += v[j].xy * v[j].xy; _s2 += v[j].zw * v[j].zw; } \
        int _ri = __builtin_amdgcn_readfirstlane(__float_as_int(__builtin_amdgcn_rsqf(wave_sum(_s2[0] + _s2[1], lane) * (1.0f / D) + EPS))); asm volatile("" : "+s"(_ri)); const float _rstd = __int_as_float(_ri);     \
        fp8* _o = F_HX8 + (size_t)(m) * D; \
        _Pragma("unroll") for (int j = 0; j < 4; ++j) { const f32x4 _h = v[j] * _rstd * ga[j] + shv[j]; *(unsigned*)(_o + 4 * lane + 256 * j) = pk4_fp8(_h[0], _h[1], _h[2], _h[3]); } } while (0)
    int rowA = 0, rowB = 0; float wA = 0.f, wB = 0.f;
    if (l > 0) { moe_tilebase_to_lds(F, l - 1);
        const int mi = mstart + lane; if (lane < per && mi < mend) { rowA = moe_slot_row(F, 2 * mi); rowB = moe_slot_row(F, 2 * mi + 1); wA = F_SLOTW[2 * mi] * 0.0625f; wB = F_SLOTW[2 * mi + 1] * 0.0625f; } }
    for (int m0 = mstart; m0 < mend; ) {
        const int b = m0 < ML ? (m0 >> 11) : 16; const int e0 = (b < 16) ? ((b + 1) << 11) : mend; const int e = e0 < mend ? e0 : mend, el = e - 1;
        { const float* _mp = F_MOD + ((size_t)l * 17 + b) * 6144; const float* _g5 = F_MOD + ((size_t)(l > 0 ? l - 1 : 0) * 17 + b) * 6144 + 5 * 1024;
#pragma unroll
          for (int j = 0; j < 4; ++j) { shv[j] = *(const f32x4*)(_mp + 4 * lane + 256 * j); ga[j] = gm[j] * (*(const f32x4*)(_mp + 1024 + 4 * lane + 256 * j) + 1.0f); g5v[j] = *(const f32x4*)(_g5 + 4 * lane + 256 * j); } }
#define N1_CL(x) ((x) < el ? (x) : el)
        N1_LOAD(R0, m0); N1_LOAD(R1, N1_CL(m0 + 1)); N1_LOAD(R2, N1_CL(m0 + 2));
        for (int m = m0; m < e; m += 4) {
            N1_LOAD(R3, N1_CL(m + 3)); N1_DO(R0, m);
            N1_LOAD(R0, N1_CL(m + 4)); if (m + 1 < e) N1_DO(R1, m + 1);
            N1_LOAD(R1, N1_CL(m + 5)); if (m + 2 < e) N1_DO(R2, m + 2);
            N1_LOAD(R2, N1_CL(m + 6)); if (m + 3 < e) N1_DO(R3, m + 3);
        }
#undef N1_CL
        m0 = e;
    }
#undef N1_LOAD
#undef N1_DO
}

__device__ __forceinline__ void router_fold(const Frame& F, int l) {
    const float* rw = inptr(F, 20); const float* gffn = inptr(F, 7) + l * 1024; const float* modl = F_MOD + (size_t)l * 17 * 6144;
    for (int idx = F.bid * 512 + F.tid; idx < 17 * 32 * 64; idx += F.G * 512) { const int b = idx >> 11, s = (idx >> 6) & 31, ln = idx & 63, g = ln >> 4, e = ln & 15;
        float hi[8], lo[8];
#pragma unroll
        for (int j = 0; j < 8; ++j) { const int k = 32 * s + 8 * g + j; const float v = gffn[k] * (1.0f + modl[b * 6144 + 4 * 1024 + k]) * rw[k * 16 + e];
            const float h = __uint_as_float(cvt_pk_bf16(v, 0.f) << 16); hi[j] = h; lo[j] = v - h; }
        u32x4 wh, wl; wh.x = cvt_pk_bf16(hi[0], hi[1]); wh.y = cvt_pk_bf16(hi[2], hi[3]); wh.z = cvt_pk_bf16(hi[4], hi[5]); wh.w = cvt_pk_bf16(hi[6], hi[7]);
        wl.x = cvt_pk_bf16(lo[0], lo[1]); wl.y = cvt_pk_bf16(lo[2], lo[3]); wl.z = cvt_pk_bf16(lo[4], lo[5]); wl.w = cvt_pk_bf16(lo[6], lo[7]);
        *(u32x4*)(F_RWH + (size_t)idx * 8) = wh; *(u32x4*)(F_RWL + (size_t)idx * 8) = wl; }
    for (int idx = F.bid * 512 + F.tid; idx < 17 * 1024; idx += F.G * 512) { const int b = idx >> 10, k = idx & 1023;
        F_AF[idx] = gffn[k] * (1.0f + modl[b * 6144 + 4 * 1024 + k]); F_BF[idx] = modl[b * 6144 + 3 * 1024 + k]; }
    const int gw = F.bid * 8 + F.wave, NGW = F.G * 8, lane = F.lane;
    for (int o = gw; o < 17 * 16; o += NGW) { const int b = o >> 4, e = o & 15; float acc = 0.f;
#pragma unroll
        for (int j = 0; j < 16; ++j) { const int k = lane + 64 * j; acc += modl[b * 6144 + 3 * 1024 + k] * rw[k * 16 + e]; }
        acc = wave_sum(acc, lane); if (lane == 0) F_CB[o] = acc; }
}
__device__ __forceinline__ void route_select(const float (&lgt)[16], const float (&rb)[16], int& be0, int& be1, float& w0, float& w1) {
    float aff[16], sel[16];
#pragma unroll
    for (int e = 0; e < 16; ++e) { aff[e] = 1.0f / (1.0f + expf(-lgt[e])); sel[e] = aff[e] + rb[e]; }
    float bs = -3.0e38f, ba0 = 0.f, ba1 = 0.f; be0 = 0; be1 = 1;
#pragma unroll
    for (int gg = 0; gg < 4; ++gg) {
        float m1 = sel[4 * gg], a1 = aff[4 * gg]; int i1 = 4 * gg;
#pragma unroll
        for (int k = 1; k < 4; ++k) if (sel[4 * gg + k] > m1) { m1 = sel[4 * gg + k]; a1 = aff[4 * gg + k]; i1 = 4 * gg + k; }
        float m2 = -3.0e38f, a2 = 0.f; int i2 = 0;
#pragma unroll
        for (int k = 0; k < 4; ++k) if ((4 * gg + k) != i1 && sel[4 * gg + k] > m2) { m2 = sel[4 * gg + k]; a2 = aff[4 * gg + k]; i2 = 4 * gg + k; }
        const float gs = m1 + m2;
        if (gs > bs) { bs = gs; be0 = i1; be1 = i2; ba0 = a1; ba1 = a2; }
    }
    const float inv = 1.0f / (ba0 + ba1); w0 = ba0 * inv; w1 = ba1 * inv;
}
__device__ __forceinline__ void phase_norm2_router(const Frame& F, int l) {
    int tid_ = F.tid; asm volatile("" : "+v"(tid_));
    const int tid = tid_, lane = tid & 63, wave = F.wave;
    const int Mrows = (l == DEPTH - 1) ? ML : MT, NT16 = Mrows / 16;
    LAS unsigned char* RWHl = F.lds; LAS unsigned char* RWLl = F.lds + 32768;
    LAS f32x4* abL = (LAS f32x4*)(F.lds + 65536);
    LAS float* lgL = (LAS float*)(F.lds + 73728) + wave * 256;
    LAS float* ssp = (LAS float*)(F.lds + 81920);
    LAS float* lgp = ssp + 128;
    float rb[16];
#pragma unroll
    for (int e = 0; e < 16; ++e) rb[e] = inptr(F, 21)[e];
    int my_e0 = 0, my_e1 = 0, my_m = -1; float my_w0 = 0.f, my_w1 = 0.f;
#define N2_STAGE(b) do { \
        _Pragma("unroll") for (int i = 0; i < 4; ++i) { const int idx = tid + 512 * i; *(LAS u32x4*)(RWHl + idx * 16) = *(const u32x4*)(F_RWH + ((size_t)(b) * 2048 + idx) * 8); *(LAS u32x4*)(RWLl + idx * 16) = *(const u32x4*)(F_RWL + ((size_t)(b) * 2048 + idx) * 8); } \
        abL[tid] = *((const f32x4*)((tid < 256 ? F_AF : F_BF) + (b) * 1024) + (tid & 255)); } while (0)
    const int t1 = F.bid * 8 + wave;
    if (F.bid * 8 < NT16) {
        const int b = (128 * F.bid < ML) ? ((128 * F.bid) >> 11) : 16;
        N2_STAGE(b);
        __syncthreads();
        if (t1 < NT16) {
            int g_ = lane >> 4, r_ = lane & 15; asm volatile("" : "+v"(g_), "+v"(r_) :: "memory");
            const int g = g_, r = r_;
            const int m = 16 * t1 + r;
            const bf16* xrow = F_XB + (size_t)m * D + 8 * g;
            u32x4 xr[32];
#pragma unroll
            for (int s = 0; s < 32; ++s) xr[s] = *(const u32x4*)(xrow + 32 * s);
            float ss = 0.f;
#pragma unroll
            for (int s = 0; s < 32; ++s) { const u32x4 w = xr[s];
                const float a0 = bflo(w.x), a1 = bfhi(w.x), a2 = bflo(w.y), a3 = bfhi(w.y), a4 = bflo(w.z), a5 = bfhi(w.z), a6 = bflo(w.w), a7 = bfhi(w.w);
                ss += ((a0 * a0 + a1 * a1) + (a2 * a2 + a3 * a3)) + ((a4 * a4 + a5 * a5) + (a6 * a6 + a7 * a7)); }
            ss += shx(ss, 16, lane); ss += shx(ss, 32, lane);
            const float rstd = 1.0f / sqrtf(ss * (1.0f / D) + EPS);
            f32x4 acc = (f32x4){0.f, 0.f, 0.f, 0.f};
#pragma unroll
            for (int s = 0; s < 32; ++s) { const bf16x8 bh = *(const LAS bf16x8*)(RWHl + (s * 64 + lane) * 16), bl = *(const LAS bf16x8*)(RWLl + (s * 64 + lane) * 16); const bf16x8 xa = __builtin_bit_cast(bf16x8, xr[s]);
                acc = __builtin_amdgcn_mfma_f32_16x16x32_bf16(xa, bh, acc, 0, 0, 0); acc = __builtin_amdgcn_mfma_f32_16x16x32_bf16(xa, bl, acc, 0, 0, 0); }
            fp8* orow = F_HX8 + (size_t)m * D + 8 * g;
#pragma unroll
            for (int s = 0; s < 32; ++s) { const int k4 = 8 * s + 2 * g; u32x4 w = xr[s]; asm volatile("" : "+v"(w));
                const f32x4 a0 = abL[k4], a1 = abL[k4 + 1], h0 = abL[256 + k4], h1 = abL[256 + k4 + 1];
                const f32x4 x0 = (f32x4){bflo(w.x), bfhi(w.x), bflo(w.y), bfhi(w.y)}, x1 = (f32x4){bflo(w.z), bfhi(w.z), bflo(w.w), bfhi(w.w)};
                const f32x4 y0 = x0 * rstd * a0 + h0, y1 = x1 * rstd * a1 + h1;
                u32x2 o; o.x = pk4_fp8(y0[0], y0[1], y0[2], y0[3]); o.y = pk4_fp8(y1[0], y1[1], y1[2], y1[3]); *(u32x2*)(orow + 32 * s) = o; }
            const float cbv = F_CB[b * 16 + r];
#pragma unroll
            for (int j = 0; j < 4; ++j) { const float rs = __int_as_float(__builtin_amdgcn_ds_bpermute((4 * g + j) << 2, __float_as_int(rstd)));
                lgL[(4 * g + j) * 16 + r] = acc[j] * rs + cbv; }
            asm volatile("s_waitcnt lgkmcnt(0)" ::: "memory");
            float lgt[16];
#pragma unroll
            for (int q4 = 0; q4 < 4; ++q4) { const f32x4 v = *(const LAS f32x4*)(lgL + r * 16 + 4 * q4); lgt[4 * q4] = v[0]; lgt[4 * q4 + 1] = v[1]; lgt[4 * q4 + 2] = v[2]; lgt[4 * q4 + 3] = v[3]; }
            int be0, be1; float w0, w1; route_select(lgt, rb, be0, be1, w0, w1);
            if ((lane >> 4) == 0) { my_e0 = be0; my_e1 = be1; my_w0 = w0; my_w1 = w1; my_m = m; }
        }
    }
    int ord = 1;
    for (int t2 = 8 * F.G + F.bid; t2 < NT16; t2 += F.G, ++ord) {
        const int m0 = 16 * t2, b = (m0 < ML) ? (m0 >> 11) : 16;
        __syncthreads();
        N2_STAGE(b);
        __syncthreads();
        int g_ = lane >> 4, r_ = lane & 15; asm volatile("" : "+v"(g_), "+v"(r_) :: "memory");
        const int g = g_, r = r_;
        const int m = m0 + r;
        const bf16* xrow = F_XB + (size_t)m * D + 8 * g + 128 * wave;
        u32x4 xq[4];
#pragma unroll
        for (int s = 0; s < 4; ++s) xq[s] = *(const u32x4*)(xrow + 32 * s);
        float ss = 0.f; f32x4 acc = (f32x4){0.f, 0.f, 0.f, 0.f};
#pragma unroll
        for (int s = 0; s < 4; ++s) { const u32x4 w = xq[s]; const int sg = 4 * wave + s;
            const float a0 = bflo(w.x), a1 = bfhi(w.x), a2 = bflo(w.y), a3 = bfhi(w.y), a4 = bflo(w.z), a5 = bfhi(w.z), a6 = bflo(w.w), a7 = bfhi(w.w);
            ss += ((a0 * a0 + a1 * a1) + (a2 * a2 + a3 * a3)) + ((a4 * a4 + a5 * a5) + (a6 * a6 + a7 * a7));
            const bf16x8 bh = *(const LAS bf16x8*)(RWHl + (sg * 64 + lane) * 16), bl = *(const LAS bf16x8*)(RWLl + (sg * 64 + lane) * 16); const bf16x8 xa = __builtin_bit_cast(bf16x8, w);
            acc = __builtin_amdgcn_mfma_f32_16x16x32_bf16(xa, bh, acc, 0, 0, 0); acc = __builtin_amdgcn_mfma_f32_16x16x32_bf16(xa, bl, acc, 0, 0, 0); }
        ss += shx(ss, 16, lane); ss += shx(ss, 32, lane);
        if (g == 0) ssp[wave * 16 + r] = ss;
#pragma unroll
        for (int j = 0; j < 4; ++j) lgp[wave * 256 + (4 * g + j) * 16 + r] = acc[j];
        __syncthreads();
        float tot = 0.f;
#pragma unroll
        for (int w = 0; w < 8; ++w) tot += ssp[w * 16 + r];
        const float rstd = 1.0f / sqrtf(tot * (1.0f / D) + EPS);
        fp8* orow = F_HX8 + (size_t)m * D + 8 * g + 128 * wave;
#pragma unroll
        for (int s = 0; s < 4; ++s) { const int k4 = 8 * (4 * wave + s) + 2 * g; const u32x4 w = xq[s];
            const f32x4 a0 = abL[k4], a1 = abL[k4 + 1], h0 = abL[256 + k4], h1 = abL[256 + k4 + 1];
            const f32x4 x0 = (f32x4){bflo(w.x), bfhi(w.x), bflo(w.y), bfhi(w.y)}, x1 = (f32x4){bflo(w.z), bfhi(w.z), bflo(w.w), bfhi(w.w)};
            const f32x4 y0 = x0 * rstd * a0 + h0, y1 = x1 * rstd * a1 + h1;
            u32x2 o; o.x = pk4_fp8(y0[0], y0[1], y0[2], y0[3]); o.y = pk4_fp8(y1[0], y1[1], y1[2], y1[3]); *(u32x2*)(orow + 32 * s) = o; }
        if (wave == 0) {
            float lgt[16];
#pragma unroll
            for (int q4 = 0; q4 < 4; ++q4) { f32x4 v = (f32x4){0.f, 0.f, 0.f, 0.f};
#pragma unroll
                for (int w = 0; w < 8; ++w) v += *(const LAS f32x4*)(lgp + w * 256 + r * 16 + 4 * q4);
                const f32x4 cb4 = *(const f32x4*)(F_CB + b * 16 + 4 * q4);
                lgt[4 * q4] = v[0] * rstd + cb4[0]; lgt[4 * q4 + 1] = v[1] * rstd + cb4[1]; lgt[4 * q4 + 2] = v[2] * rstd + cb4[2]; lgt[4 * q4 + 3] = v[3] * rstd + cb4[3]; }
            int be0, be1; float w0, w1; route_select(lgt, rb, be0, be1, w0, w1);
            if ((lane >> 4) == ord) { my_e0 = be0; my_e1 = be1; my_w0 = w0; my_w1 = w1; my_m = m; }
        }
    }
#undef N2_STAGE
    __syncthreads();
    {
        LAS int* cntw = (LAS int*)(F.lds + 98304);
        LAS int* baseL = cntw + 128;
        const bool valid = my_m >= 0; const unsigned long long lt = (1ull << lane) - 1ull;
        int r0 = 0, r1 = 0, mycnt = 0;
#pragma unroll
        for (int e = 0; e < 16; ++e) {
            const unsigned long long m0 = __ballot(valid && my_e0 == e), m1 = __ballot(valid && my_e1 == e);
            if (my_e0 == e) r0 = __popcll(m0 & lt);
            if (my_e1 == e) r1 = __popcll(m0) + __popcll(m1 & lt);
            if (lane == e) mycnt = __popcll(m0) + __popcll(m1);
        }
        if (lane < 16) cntw[wave * 16 + lane] = mycnt;
        __syncthreads();
        if (tid < 16) { int tot = 0;
#pragma unroll
            for (int w = 0; w < 8; ++w) { const int c = cntw[w * 16 + tid]; cntw[w * 16 + tid] = tot; tot += c; }
            baseL[tid] = (int)atomicAdd(F_CTL + CW_MOE + (l * 16 + tid) * 64, (unsigned)tot); }
        __syncthreads();
        if (valid) {
            F_SLOTW[2 * my_m] = my_w0; F_SLOTW[2 * my_m + 1] = my_w1;
            const int p0 = baseL[my_e0] + cntw[wave * 16 + my_e0] + r0, p1 = baseL[my_e1] + cntw[wave * 16 + my_e1] + r1;
            F_LIST[(size_t)my_e0 * MT + p0] = 2 * my_m; F_LIST[(size_t)my_e1 * MT + p1] = 2 * my_m + 1;
            F_SPOS[2 * my_m] = (my_e0 << 20) | p0; F_SPOS[2 * my_m + 1] = (my_e1 << 20) | p1;
        }
    }
    __syncthreads();
}

__device__ __forceinline__ void moe_setup(const Frame& F, int l, MoeOrder& S, int NT) {
    LAS int* tab = (LAS int*)(F.lds + LDS_MOE);
    LAS int* rows = (LAS int*)(F.lds + LDS_ROWS);
    if (F.tid < 16) tab[F.tid] = (int)__hip_atomic_load(F_CTL + CW_MOE + (l * 16 + F.tid) * 64, __ATOMIC_RELAXED, __HIP_MEMORY_SCOPE_AGENT);
    __syncthreads();
    if (F.tid == 0) { int acc = 0;
#pragma unroll
        for (int e = 0; e < 16; ++e) { tab[16 + e] = acc; acc += (tab[e] + 255) >> 8; }
        tab[32] = acc; }
    __syncthreads();
    S.mbase = tab + 16; S.rows = rows; S.NT = NT; S.G = F.G; S.c = F.bid; S.TM = __builtin_amdgcn_readfirstlane(tab[32]); S.rowbytes = 1024u;
    if (NT == 8 && F.tid < 256) {
        int val[MAXU]; bool keep[MAXU];
#pragma unroll
        for (int i = 0; i < MAXU; ++i) { pg8::Unit u; const bool ok = S.next(i, u);
            const int e = ok ? u.pn / NT : 0, jt = ok ? u.pm - tab[16 + e] : 0, r = jt * 256 + F.tid; const bool in = ok && (r < tab[e]);
            val[i] = F_LIST[(size_t)e * MT + (in ? r : 0)]; keep[i] = in; }
#pragma unroll
        for (int i = 0; i < MAXU; ++i) rows[i * 256 + F.tid] = keep[i] ? val[i] : -1;
    }
    __syncthreads();
}

__device__ __forceinline__ void na_unit(const Frame& F, int l, int kind, int b, int h, int idx) {
    LAS unsigned char* Kl = F.lds;
    LAS float* rpbL = (LAS float*)(F.lds + 110592);
    LAS float* mrg = (LAS float*)(F.lds + 112640);
    const int tid = F.tid, lane = F.lane, w = F.wave, g = lane >> 4, c = lane & 15, qb = w & 3, part = w >> 2;
    const int r = idx, r0 = (r - 4 < 0) ? 0 : ((r - 4 > 24) ? 24 : r - 4);
    const bf16* px = F_PX;
#define NA_STAGE(COL) do { \
        if (kind == 0) { \
            _Pragma("unroll") for (int k = 0; k < 8; ++k) { const int ch = tid + 512 * k, key = ch >> 3, p = ch & 7; \
                *(LAS u32x4*)(Kl + key * 144 + p * 16) = *(const u32x4*)(((COL) == C_NK ? F_KNL : F_VNL) + ((size_t)(b * 6 + h) * 2048 + r0 * 64) * 64 + ch * 8); } \
            _Pragma("unroll") for (int k = 0; k < 4; ++k) { const int ch = tid + 512 * k, key = ch >> 3, p = ch & 7; \
                *(LAS u32x4*)(Kl + (512 + key) * 144 + p * 16) = *(const u32x4*)(((COL) == C_NK ? F_KNC : F_VNC) + (size_t)(b * 6 + h) * 256 * 64 + ch * 8); } \
        } else { \
            _Pragma("unroll") for (int k = 0; k < 6; ++k) { const int ch = tid + 512 * k, row = ch >> 3, p = ch & 7; \
                *(LAS u32x4*)(Kl + row * 144 + p * 16) = *(const u32x4*)(((COL) == C_NK ? F_KNC : F_VNC) + ((size_t)(b * 6 + h) * 256 + (row & 255)) * 64 + p * 8); } \
        } } while (0)
    NA_STAGE(C_NK);
    if (kind == 0) { const float* rp = inptr(F, 14) + ((size_t)l * 6 + h) * 465; for (int i = tid; i < 465; i += 512) rpbL[i] = rp[i]; }
    const int mq = (kind == 0) ? (b * 2048 + r * 64 + 16 * qb + c) : (ML + b * 256 + idx * 64 + 16 * qb + c);
    const bf16x8 q0 = *(const bf16x8*)(px + (size_t)mq * NPX + C_NQ + h * 64 + 8 * g), q1 = *(const bf16x8*)(px + (size_t)mq * NPX + C_NQ + h * 64 + 32 + 8 * g);
    __syncthreads();
    const int cs = (kind == 0) ? (qb == 0 ? 0 : (qb == 1 ? 8 : (qb == 2 ? 24 : 32))) : 0;
    const int kbase = (kind == 0) ? (part == 0 ? cs : 512) : part * 128;
    const int st2 = ((kind == 0 && part == 0) ? 64 : 32) * 144;
    const int abase = (kbase + c) * 144 + 16 * g;
    f32x4 s[16];
#pragma unroll
    for (int t = 0; t < 16; ++t) {
        const LAS unsigned char* kp = Kl + abase + (t >> 1) * st2 + (t & 1) * 2304;
        const bf16x8 a0 = *(const LAS bf16x8*)(kp), a1 = *(const LAS bf16x8*)(kp + 64);
        f32x4 z = (f32x4){0.f, 0.f, 0.f, 0.f};
        z = __builtin_amdgcn_mfma_f32_16x16x32_bf16(a0, q0, z, 0, 0, 0);
        z = __builtin_amdgcn_mfma_f32_16x16x32_bf16(a1, q1, z, 0, 0, 0);
        s[t] = z;
    }
    const float NEG = -__builtin_inff();
    if (kind == 0 && part == 0) {
        const int cq = 16 * qb + c, c0 = (cq - 8 < 0) ? 0 : ((cq - 8 > 48) ? 48 : cq - 8);
#pragma unroll
        for (int t = 0; t < 16; ++t) { const int i = t >> 1, drow = r0 + i - r + 7;
#pragma unroll
            for (int j = 0; j < 4; ++j) { const int col = cs + 16 * (t & 1) + 4 * g + j; const bool valid = (col >= c0) && (col < c0 + 16);
                int dcol = col - cq + 15; dcol = dcol < 0 ? 0 : (dcol > 30 ? 30 : dcol);
                const float bias = rpbL[drow * 31 + dcol];
                s[t][j] = valid ? (s[t][j] * 0.125f + bias) : NEG; } }
    } else if (kind == 0) {
#pragma unroll
        for (int t = 0; t < 16; ++t) s[t] = s[t] * 0.125f;
    } else {
#pragma unroll
        for (int t = 0; t < 16; ++t) {
#pragma unroll
            for (int j = 0; j < 4; ++j) s[t][j] = (t < 8) ? s[t][j] * 0.125f : NEG; }
    }
    float mx = NEG;
#pragma unroll
    for (int t = 0; t < 16; ++t)
#pragma unroll
        for (int j = 0; j < 4; ++j) mx = fmaxf(mx, s[t][j]);
    mx = fmaxf(mx, shx(mx, 16, lane)); mx = fmaxf(mx, shx(mx, 32, lane));
    float lsum = 0.f;
#pragma unroll
    for (int t = 0; t < 16; ++t)
#pragma unroll
        for (int j = 0; j < 4; ++j) { const float p = __expf(s[t][j] - mx); s[t][j] = p; lsum += p; }
    lsum += shx(lsum, 16, lane); lsum += shx(lsum, 32, lane);
    __syncthreads();
    NA_STAGE(C_NV);
    __syncthreads();
    f32x4 o[4];
#pragma unroll
    for (int nt = 0; nt < 4; ++nt) o[nt] = (f32x4){0.f, 0.f, 0.f, 0.f};
    const int vbase = (kbase + 4 * g + (c >> 2)) * 144 + 8 * (c & 3);
#pragma unroll
    for (int ks = 0; ks < 8; ++ks) {
        bf16x8 pb; { const unsigned w0 = cvt_pk_bf16(s[2 * ks][0], s[2 * ks][1]), w1 = cvt_pk_bf16(s[2 * ks][2], s[2 * ks][3]), w2 = cvt_pk_bf16(s[2 * ks + 1][0], s[2 * ks + 1][1]), w3 = cvt_pk_bf16(s[2 * ks + 1][2], s[2 * ks + 1][3]);
            u32x4 pw = (u32x4){w0, w1, w2, w3}; pb = __builtin_bit_cast(bf16x8, pw); }
        LAS unsigned char* vp = Kl + vbase + ks * st2;
#pragma unroll
        for (int nt = 0; nt < 4; ++nt) {
            const s16x4 t0 = __builtin_amdgcn_ds_read_tr16_b64_v4i16((LAS s16x4*)(vp + 32 * nt));
            const s16x4 t1 = __builtin_amdgcn_ds_read_tr16_b64_v4i16((LAS s16x4*)(vp + 2304 + 32 * nt));
            const bf16x8 va = (bf16x8){t0[0], t0[1], t0[2], t0[3], t1[0], t1[1], t1[2], t1[3]};
            o[nt] = __builtin_amdgcn_mfma_f32_16x16x32_bf16(va, pb, o[nt], 0, 0, 0);
        }
    }
    if (part == 1) { LAS float* mp = mrg + (qb * 64 + lane) * 18; mp[0] = mx; mp[1] = lsum;
#pragma unroll
        for (int nt = 0; nt < 4; ++nt)
#pragma unroll
            for (int j = 0; j < 4; ++j) mp[2 + 4 * nt + j] = o[nt][j]; }
    __syncthreads();
    if (part == 0) { const LAS float* mp = mrg + (qb * 64 + lane) * 18; const float m2 = mp[0], l2 = mp[1];
        const float M = fmaxf(mx, m2), f1 = __expf(mx - M), f2 = __expf(m2 - M), inv = 1.0f / (lsum * f1 + l2 * f2);
        fp8* op = F_MIX + (size_t)mq * D + 384 + h * 64 + 4 * g;
#pragma unroll
        for (int nt = 0; nt < 4; ++nt) { float r4[4];
#pragma unroll
            for (int j = 0; j < 4; ++j) r4[j] = (o[nt][j] * f1 + mp[2 + 4 * nt + j] * f2) * inv;
            *(unsigned*)(op + 16 * nt) = pk4_fp8(r4[0], r4[1], r4[2], r4[3]); } }
    __syncthreads();
#undef NA_STAGE
}

__device__ __forceinline__ void na_latent_phase(const Frame& F, int l) {
    LAS unsigned char* Kl = F.lds;
    LAS float* rpbL = (LAS float*)(F.lds + 110592);
    LAS float* mrg = (LAS float*)(F.lds + 112640);
    int tid_ = F.tid; asm volatile("" : "+v"(tid_));
    const int tid = tid_, lane = tid & 63, w = F.wave, g = lane >> 4, c = lane & 15, qb = w & 3, part = w >> 2;
    const bf16* px = F_PX;
    const int r = F.bid >> 3, r0 = (r - 4 < 0) ? 0 : ((r - 4 > 24) ? 24 : r - 4), bh0 = F.bid & 7;
    u32x4 kv[12]; bf16x8 qn0, qn1; float rpn = 0.f;
#define NA_LOAD(COL, ii) do { const int _bh = bh0 + 8 * (ii), _b = _bh / 6, _h = _bh % 6; \
        _Pragma("unroll") for (int k = 0; k < 8; ++k) { const int ch = tid + 512 * k; \
            kv[k] = *(const u32x4*)(((COL) == C_NK ? F_KNL : F_VNL) + ((size_t)(_b * 6 + _h) * 2048 + r0 * 64) * 64 + ch * 8); }        \
        _Pragma("unroll") for (int k = 0; k < 4; ++k) { const int ch = tid + 512 * k; \
            kv[8 + k] = *(const u32x4*)(((COL) == C_NK ? F_KNC : F_VNC) + (size_t)(_b * 6 + _h) * 256 * 64 + ch * 8); } } while (0)
#define NA_PUT() do { \
        _Pragma("unroll") for (int k = 0; k < 8; ++k) { const int ch = tid + 512 * k, key = ch >> 3, p = ch & 7; *(LAS u32x4*)(Kl + key * 144 + p * 16) = kv[k]; } \
        _Pragma("unroll") for (int k = 0; k < 4; ++k) { const int ch = tid + 512 * k, key = ch >> 3, p = ch & 7; *(LAS u32x4*)(Kl + (512 + key) * 144 + p * 16) = kv[8 + k]; } } while (0)
#define NA_LOADQ(ii) do { const int _bh = bh0 + 8 * (ii), _b = _bh / 6, _h = _bh % 6; const int _mq = _b * 2048 + r * 64 + 16 * qb + c; \
        qn0 = *(const bf16x8*)(px + (size_t)_mq * NPX + C_NQ + _h * 64 + 8 * g); qn1 = *(const bf16x8*)(px + (size_t)_mq * NPX + C_NQ + _h * 64 + 32 + 8 * g); \
        if (tid < 465) rpn = inptr(F, 14)[((size_t)l * 6 + _h) * 465 + tid]; } while (0)
    NA_LOAD(C_NK, 0); NA_LOADQ(0);
    const int cs = (qb == 0 ? 0 : (qb == 1 ? 8 : (qb == 2 ? 24 : 32)));
    const int kbase = (part == 0 ? cs : 512), st2 = (part == 0 ? 64 : 32) * 144;
    const int abase = (kbase + c) * 144 + 16 * g, vbase = (kbase + 4 * g + (c >> 2)) * 144 + 8 * (c & 3);
    const float NEG = -__builtin_inff();
    int bcol[8];
    { const int cq = 16 * qb + c, c0 = (cq - 8 < 0) ? 0 : ((cq - 8 > 48) ? 48 : cq - 8);
#pragma unroll
      for (int k = 0; k < 8; ++k) { const int col = cs + 16 * (k >> 2) + 4 * g + (k & 3); const bool valid = (col >= c0) && (col < c0 + 16);
          int dcol = col - cq + 15; dcol = dcol < 0 ? 0 : (dcol > 30 ? 30 : dcol); bcol[k] = valid ? dcol : 31; } }
    const int rpw = (tid < 465) ? (tid / 31) * 32 + tid % 31 : 0;
    for (int i = 0; i < 12; ++i) {
        const int bh = bh0 + 8 * i, b = bh / 6, h = bh % 6;
        NA_PUT();
        if (tid < 465) rpbL[rpw] = rpn * 1.4426950408889634f; else if (tid < 480) rpbL[(tid - 465) * 32 + 31] = NEG;
        const bf16x8 q0 = qn0, q1 = qn1;
        NA_LOAD(C_NV, i);
        __syncthreads();
        f32x4 s[16];
#pragma unroll
        for (int t = 0; t < 16; ++t) {
            const LAS unsigned char* kp = Kl + abase + (t >> 1) * st2 + (t & 1) * 2304;
            const bf16x8 a0 = *(const LAS bf16x8*)(kp), a1 = *(const LAS bf16x8*)(kp + 64);
            f32x4 z = (f32x4){0.f, 0.f, 0.f, 0.f};
            z = __builtin_amdgcn_mfma_f32_16x16x32_bf16(a0, q0, z, 0, 0, 0);
            z = __builtin_amdgcn_mfma_f32_16x16x32_bf16(a1, q1, z, 0, 0, 0);
            s[t] = z;
        }
        constexpr float L2E = 1.4426950408889634f;
        if (part == 0) {
#pragma unroll
            for (int t = 0; t < 16; ++t) { const LAS float* brow = rpbL + (r0 + (t >> 1) - r + 7) * 32; const int k0 = 4 * (t & 1);
                f32x4 bias; bias[0] = brow[bcol[k0]]; bias[1] = brow[bcol[k0 + 1]]; bias[2] = brow[bcol[k0 + 2]]; bias[3] = brow[bcol[k0 + 3]];
                s[t] = s[t] * (0.125f * L2E) + bias; }
        } else {
#pragma unroll
            for (int t = 0; t < 16; ++t) s[t] = s[t] * (0.125f * L2E);
        }
        float mx;
        { f32x4 m4 = s[0];
#pragma unroll
          for (int t = 1; t < 16; ++t) { m4[0] = fmaxf(m4[0], s[t][0]); m4[1] = fmaxf(m4[1], s[t][1]); m4[2] = fmaxf(m4[2], s[t][2]); m4[3] = fmaxf(m4[3], s[t][3]); }
          mx = fmaxf(fmaxf(m4[0], m4[1]), fmaxf(m4[2], m4[3])); }
        mx = fmaxf(mx, shx(mx, 16, lane)); mx = fmaxf(mx, shx(mx, 32, lane));
        float lsum;
        { f32x4 l4 = (f32x4){0.f, 0.f, 0.f, 0.f};
#pragma unroll
          for (int t = 0; t < 16; ++t) { const f32x4 d = s[t] - mx; f32x4 p; p[0] = __builtin_amdgcn_exp2f(d[0]); p[1] = __builtin_amdgcn_exp2f(d[1]); p[2] = __builtin_amdgcn_exp2f(d[2]); p[3] = __builtin_amdgcn_exp2f(d[3]); s[t] = p; l4 += p; }
          lsum = (l4[0] + l4[1]) + (l4[2] + l4[3]); }
        lsum += shx(lsum, 16, lane); lsum += shx(lsum, 32, lane);
        __syncthreads();
        NA_PUT();
        if (i + 1 < 12) { NA_LOAD(C_NK, i + 1); NA_LOADQ(i + 1); }
        __syncthreads();
        f32x4 o[4];
#pragma unroll
        for (int nt = 0; nt < 4; ++nt) o[nt] = (f32x4){0.f, 0.f, 0.f, 0.f};
#pragma unroll
        for (int ks = 0; ks < 8; ++ks) {
            bf16x8 pb; { u32x4 pw = (u32x4){cvt_pk_bf16(s[2 * ks][0], s[2 * ks][1]), cvt_pk_bf16(s[2 * ks][2], s[2 * ks][3]), cvt_pk_bf16(s[2 * ks + 1][0], s[2 * ks + 1][1]), cvt_pk_bf16(s[2 * ks + 1][2], s[2 * ks + 1][3])}; pb = __builtin_bit_cast(bf16x8, pw); }
            LAS unsigned char* vp = Kl + vbase + ks * st2;
#pragma unroll
            for (int nt = 0; nt < 4; ++nt) {
                const s16x4 t0 = __builtin_amdgcn_ds_read_tr16_b64_v4i16((LAS s16x4*)(vp + 32 * nt));
                const s16x4 t1 = __builtin_amdgcn_ds_read_tr16_b64_v4i16((LAS s16x4*)(vp + 2304 + 32 * nt));
                const bf16x8 va = (bf16x8){t0[0], t0[1], t0[2], t0[3], t1[0], t1[1], t1[2], t1[3]};
                o[nt] = __builtin_amdgcn_mfma_f32_16x16x32_bf16(va, pb, o[nt], 0, 0, 0);
            }
        }
        if (part == 1) { LAS float* mp = mrg + (qb * 64 + lane) * 18; mp[0] = mx; mp[1] = lsum;
#pragma unroll
            for (int nt = 0; nt < 4; ++nt)
#pragma unroll
                for (int j = 0; j < 4; ++j) mp[2 + 4 * nt + j] = o[nt][j]; }
        __syncthreads();
        if (part == 0) { const LAS float* mp = mrg + (qb * 64 + lane) * 18; const float m2 = mp[0], l2 = mp[1];
            const float M = fmaxf(mx, m2), f1 = __builtin_amdgcn_exp2f(mx - M), f2 = __builtin_amdgcn_exp2f(m2 - M), inv = 1.0f / (lsum * f1 + l2 * f2);
            const int mq = b * 2048 + r * 64 + 16 * qb + c;
            fp8* op = F_MIX + (size_t)mq * D + 384 + h * 64 + 4 * g;
#pragma unroll
            for (int nt = 0; nt < 4; ++nt) { float r4[4];
#pragma unroll
                for (int j = 0; j < 4; ++j) r4[j] = (o[nt][j] * f1 + mp[2 + 4 * nt + j] * f2) * inv;
                *(unsigned*)(op + 16 * nt) = pk4_fp8(r4[0], r4[1], r4[2], r4[3]); } }
    }
    __syncthreads();
#undef NA_LOAD
#undef NA_PUT
#undef NA_LOADQ
}

__device__ __forceinline__ void conv_unit(const Frame& F, int l, int mbase, int len, int t0) {
    LAS float* hcv = (LAS float*)F.lds;
    LAS float* ob = (LAS float*)(F.lds + 62 * 256 * 4);
    const int tid = F.tid, lane = F.lane;
    const bf16* px = F_PX;
    for (int ch = tid; ch < 62 * 32; ch += 512) { const int rr = ch >> 5, c8 = (ch & 31) * 8, t = t0 - 15 + rr;
        f32x4 lo = (f32x4){0.f, 0.f, 0.f, 0.f}, hi = lo;
        if (t >= 0 && t < len) { const bf16* p = px + (size_t)(mbase + t) * NPX; const u32x4 a = *(const u32x4*)(p + C_CV + c8), gt = *(const u32x4*)(p + C_CG + c8);
            lo[0] = bflo(a.x) * sigmoid_f(bflo(gt.x)); lo[1] = bfhi(a.x) * sigmoid_f(bfhi(gt.x)); lo[2] = bflo(a.y) * sigmoid_f(bflo(gt.y)); lo[3] = bfhi(a.y) * sigmoid_f(bfhi(gt.y));
            hi[0] = bflo(a.z) * sigmoid_f(bflo(gt.z)); hi[1] = bfhi(a.z) * sigmoid_f(bfhi(gt.z)); hi[2] = bflo(a.w) * sigmoid_f(bflo(gt.w)); hi[3] = bfhi(a.w) * sigmoid_f(bfhi(gt.w)); }
        *(LAS f32x4*)(hcv + rr * 256 + c8) = lo; *(LAS f32x4*)(hcv + rr * 256 + c8 + 4) = hi; }
    const int c = tid & 255, th = tid >> 8;
    float wv[31];
#pragma unroll
    for (int j = 0; j < 31; ++j) wv[j] = inptr(F, 15)[((size_t)l * 31 + j) * 256 + c];
    const float bias = inptr(F, 16)[l * 256 + c];
    __syncthreads();
    float acc[16];
#pragma unroll
    for (int i = 0; i < 16; ++i) acc[i] = bias;
#pragma unroll
    for (int rr = 0; rr < 46; ++rr) { const float x = hcv[(th * 16 + rr) * 256 + c];
#pragma unroll
        for (int i = 0; i < 16; ++i) { const int j = rr - i; if (j >= 0 && j < 31) acc[i] += x * wv[j]; } }
#pragma unroll
    for (int i = 0; i < 16; ++i) ob[(th * 16 + i) * 256 + c] = acc[i];
    __syncthreads();
    const f32x4 lg = *(const f32x4*)(inptr(F, 17) + l * 256 + 4 * lane), lb = *(const f32x4*)(inptr(F, 18) + l * 256 + 4 * lane);
#pragma unroll
    for (int k = 0; k < 4; ++k) { const int tt = F.wave * 4 + k; const f32x4 x = *(const LAS f32x4*)(ob + tt * 256 + 4 * lane);
        const float mean = wave_sum((x[0] + x[1]) + (x[2] + x[3]), lane) * (1.0f / 256.0f); const f32x4 d = x - mean;
        const float var = wave_sum((d[0] * d[0] + d[1] * d[1]) + (d[2] * d[2] + d[3] * d[3]), lane) * (1.0f / 256.0f); const float rstd = 1.0f / sqrtf(var + EPS);
        const f32x4 y = d * rstd * lg + lb;
        *(unsigned*)(F_MIX + (size_t)(mbase + t0 + tt) * D + 768 + 4 * lane) = pk4_fp8(silu_f(y[0]), silu_f(y[1]), silu_f(y[2]), silu_f(y[3])); }
    __syncthreads();
}

constexpr int GB_TOT = 0;
constexpr int GB_X = 6144;
constexpr int GB_V = 8192;
constexpr int GB_T = GB_V + 64 * 208;
constexpr int GB_SF = GB_T + 4 * 64 * 144, GB_SB = GB_SF + 64 * 208;
constexpr int VST = 208, TST = 144;
static_assert(GB_SB + 64 * VST <= SCR_BYTES, "GLA LDS map");
__device__ __forceinline__ void gla_chunk_info(int b, int cc, int& m0, bool& lat, int& rowpos, int& idxf, int& idxb) {
    lat = cc >= 4;
    if (lat) { const int cl = cc - 4; m0 = b * 2048 + cl * 64; rowpos = cl; idxf = 4 + cl; idxb = 4 + (31 - cl); }
    else { m0 = ML + b * 256 + cc * 64; rowpos = 0; idxf = cc; idxb = 3 - cc; }
}
__device__ __forceinline__ bf16x8 tr_pair(const LAS unsigned char* p0, const LAS unsigned char* p1) {
    const s16x4 t0 = __builtin_amdgcn_ds_read_tr16_b64_v4i16((LAS s16x4*)p0), t1 = __builtin_amdgcn_ds_read_tr16_b64_v4i16((LAS s16x4*)p1);
    return (bf16x8){t0[0], t0[1], t0[2], t0[3], t1[0], t1[1], t1[2], t1[3]};
}
template <bool G3>
__device__ __forceinline__ void gla_stage(const Frame& F, int l, int b, int h, int m0, bool lat, int rowpos, int idxf, int idxb) {
    int tid_ = F.tid; asm volatile("" : "+v"(tid_));
    const int tid = tid_; const bf16* px = F_PX;
    LAS float* TOT = (LAS float*)(F.lds + GB_TOT);
    const size_t chainf = ((size_t)(0 * 16 + b) * 4 + h), chainb = ((size_t)(1 * 16 + b) * 4 + h);
    if (tid >= 384) {
        const int at = tid - 384;
#pragma unroll
        for (int i = 0; i < 6; ++i) { const int idx = at + 128 * i, t = idx / 12, ch = idx % 12;
            *(LAS u32x4*)(F.lds + GB_V + t * VST + ch * 16) = *(const u32x4*)(px + (size_t)(m0 + t) * NPX + C_GV + h * 96 + ch * 8); }
        if constexpr (G3) {
            for (int i = at; i < 2 * 16 * 13; i += 128) { const int dir = i / 208, r = i % 208, d = 48 + r / 13, ch = r % 13; *(LAS u32x4*)(F.lds + (dir ? GB_SB : GB_SF) + d * VST + ch * 16) = (u32x4){0u, 0u, 0u, 0u}; }
            for (int i = at; i < 512; i += 128) { const int row = i >> 1, hf = i & 1; *(LAS u32x4*)(F.lds + GB_T + row * TST + 96 + hf * 16) = (u32x4){0u, 0u, 0u, 0u}; }
        }
    }
    u32x4 sx[3];
    if constexpr (G3) {
        const bf16* gf = F_GST + (chainf * NCH + idxf) * 4608; const bf16* gb = F_GST + (chainb * NCH + idxb) * 4608;
#pragma unroll
        for (int i = 0; i < 3; ++i) { const int idx = tid + 512 * i; if (idx < 1152) { const int dirs = idx / 576, rr = idx % 576; sx[i] = *(const u32x4*)((dirs ? gb : gf) + rr * 8); } }
    }
    float pr_[4][4]; float kk[4][4], qq[4][4];
    const int dir = (tid >= 192) ? 1 : 0, r_ = tid - 192 * dir, dg = r_ >> 4, tg = r_ & 15;
    float* pvg = F_PV + ((((size_t)(b * 4 + h) * NCH + idxf) * 2 + dir) * 64 + 4 * tg) * 48 + 4 * dg;
    f32x4 pvl[4];
    if (tid < 384) {
        u32x4 araw[4][2]; f32x4 wv[16]; f32x4 bav;
        if constexpr (!G3) {
#pragma unroll
        for (int t = 0; t < 4; ++t) { const bf16* ap = px + (size_t)(m0 + 4 * tg + t) * NPX + C_GA + 16 * dir; araw[t][0] = *(const u32x4*)ap; araw[t][1] = *(const u32x4*)(ap + 8); }
        const float* wa = inptr(F, dir ? 11 : 9) + (size_t)l * 16 * 192 + h * 48 + 4 * dg;
#pragma unroll
        for (int j = 0; j < 16; ++j) wv[j] = *(const f32x4*)(wa + j * 192);
        bav = *(const f32x4*)(inptr(F, dir ? 12 : 10) + l * 192 + h * 48 + 4 * dg);
        } else {
#pragma unroll
        for (int t = 0; t < 4; ++t) pvl[t] = *(const f32x4*)(pvg + t * 48);
        }
        u32x2 kraw[4], qraw[4];
#pragma unroll
        for (int t = 0; t < 4; ++t) { const bf16* rp = px + (size_t)(m0 + 4 * tg + t) * NPX + h * 48 + 4 * dg; kraw[t] = *(const u32x2*)(rp + C_GK); if constexpr (G3) qraw[t] = *(const u32x2*)(rp + C_GQ); }
        f32x4 rope[4];
        if (lat) {
#pragma unroll
            for (int t = 0; t < 4; ++t) { const int pos = (dg < 6) ? rowpos : (4 * tg + t), j = (dg < 6) ? 2 * dg : 2 * dg - 12; rope[t] = *(const f32x4*)(F_ROPE + (pos * 12 + j) * 2); }
        }
        if constexpr (!G3) {
#pragma unroll
        for (int t = 0; t < 4; ++t) {
            float a[16];
#pragma unroll
            for (int i = 0; i < 4; ++i) { const unsigned w0 = araw[t][i >> 1][(i & 1) * 2], w1 = araw[t][i >> 1][(i & 1) * 2 + 1]; a[4 * i] = bflo(w0); a[4 * i + 1] = bfhi(w0); a[4 * i + 2] = bflo(w1); a[4 * i + 3] = bfhi(w1); }
            f32x4 x = bav;
#pragma unroll
            for (int j = 0; j < 16; ++j) x += wv[j] * a[j];
            { constexpr float L2E = 1.4426950408889634f;
              f32x4 tt; tt[0] = fabsf(x[0]); tt[1] = fabsf(x[1]); tt[2] = fabsf(x[2]); tt[3] = fabsf(x[3]); tt = tt * (-L2E);
              f32x4 ee; ee[0] = __builtin_amdgcn_exp2f(tt[0]); ee[1] = __builtin_amdgcn_exp2f(tt[1]); ee[2] = __builtin_amdgcn_exp2f(tt[2]); ee[3] = __builtin_amdgcn_exp2f(tt[3]);
              const f32x4 uu = ee + 1.0f;
              f32x4 lg; lg[0] = __builtin_amdgcn_logf(uu[0]); lg[1] = __builtin_amdgcn_logf(uu[1]); lg[2] = __builtin_amdgcn_logf(uu[2]); lg[3] = __builtin_amdgcn_logf(uu[3]);
              f32x4 mn; mn[0] = fminf(x[0], 0.f); mn[1] = fminf(x[1], 0.f); mn[2] = fminf(x[2], 0.f); mn[3] = fminf(x[3], 0.f);
              const f32x4 pr4 = mn * (0.0625f * L2E) - lg * 0.0625f;
              pr_[t][0] = pr4[0]; pr_[t][1] = pr4[1]; pr_[t][2] = pr4[2]; pr_[t][3] = pr4[3]; }
        }
        if (dir == 0) {
#pragma unroll
            for (int t = 1; t < 4; ++t)
#pragma unroll
                for (int d = 0; d < 4; ++d) pr_[t][d] += pr_[t - 1][d];
            *(LAS f32x4*)(TOT + (0 * 16 + tg) * 48 + 4 * dg) = (f32x4){pr_[3][0], pr_[3][1], pr_[3][2], pr_[3][3]};
        } else {
#pragma unroll
            for (int t = 2; t >= 0; --t)
#pragma unroll
                for (int d = 0; d < 4; ++d) pr_[t][d] += pr_[t + 1][d];
            *(LAS f32x4*)(TOT + (1 * 16 + tg) * 48 + 4 * dg) = (f32x4){pr_[0][0], pr_[0][1], pr_[0][2], pr_[0][3]};
        }
        }
#pragma unroll
        for (int t = 0; t < 4; ++t) {
            kk[t][0] = bflo(kraw[t].x); kk[t][1] = bfhi(kraw[t].x); kk[t][2] = bflo(kraw[t].y); kk[t][3] = bfhi(kraw[t].y);
            if constexpr (G3) { qq[t][0] = bflo(qraw[t].x) * 0.14433756729740643f; qq[t][1] = bfhi(qraw[t].x) * 0.14433756729740643f; qq[t][2] = bflo(qraw[t].y) * 0.14433756729740643f; qq[t][3] = bfhi(qraw[t].y) * 0.14433756729740643f; }
            if (lat) {
#pragma unroll
                for (int pp = 0; pp < 2; ++pp) { const float cs = rope[t][2 * pp], sn = rope[t][2 * pp + 1];
                    const float k1 = kk[t][2 * pp], k2 = kk[t][2 * pp + 1]; kk[t][2 * pp] = k1 * cs - k2 * sn; kk[t][2 * pp + 1] = k1 * sn + k2 * cs;
                    if constexpr (G3) { const float q1 = qq[t][2 * pp], q2 = qq[t][2 * pp + 1]; qq[t][2 * pp] = q1 * cs - q2 * sn; qq[t][2 * pp + 1] = q1 * sn + q2 * cs; } }
            }
        }
    }
    if constexpr (G3) {
#pragma unroll
        for (int i = 0; i < 3; ++i) { const int idx = tid + 512 * i; if (idx < 1152) { const int dirs = idx / 576, rr = idx % 576, d = rr / 12, e8 = (rr % 12) * 8;
            *(LAS u32x4*)(F.lds + (dirs ? GB_SB : GB_SF) + d * VST + e8 * 2) = sx[i]; } }
    }
    __syncthreads();
    if (tid < 384) {
        f32x4 off = (f32x4){0.f, 0.f, 0.f, 0.f}, E = off;
        if constexpr (!G3) {
        f32x4 tvs[16];
#pragma unroll
        for (int g2 = 0; g2 < 16; ++g2) tvs[g2] = *(const LAS f32x4*)(TOT + (dir * 16 + g2) * 48 + 4 * dg);
#pragma unroll
        for (int g2 = 0; g2 < 16; ++g2) { const float mk = (dir == 0 ? (g2 < tg) : (g2 > tg)) ? 1.0f : 0.0f; E += tvs[g2]; off += tvs[g2] * mk; }
        }
        LAS unsigned char* base = F.lds + GB_T + (4 * tg) * TST + 8 * dg;
#pragma unroll
        for (int t = 0; t < 4; ++t) {
            float pv[4];
            if constexpr (G3) {
#pragma unroll
                for (int d = 0; d < 4; ++d) pv[d] = pvl[t][d];
            } else {
#pragma unroll
                for (int d = 0; d < 4; ++d) pv[d] = pr_[t][d] + off[d];
                *(f32x4*)(pvg + t * 48) = (f32x4){pv[0], pv[1], pv[2], pv[3]};
            }
            if constexpr (G3) {
                u32x2 wq, wk; wq.x = cvt_pk_bf16(qq[t][0] * __builtin_amdgcn_exp2f(pv[0]), qq[t][1] * __builtin_amdgcn_exp2f(pv[1])); wq.y = cvt_pk_bf16(qq[t][2] * __builtin_amdgcn_exp2f(pv[2]), qq[t][3] * __builtin_amdgcn_exp2f(pv[3]));
                wk.x = cvt_pk_bf16(kk[t][0] * __builtin_amdgcn_exp2f(-pv[0]), kk[t][1] * __builtin_amdgcn_exp2f(-pv[1])); wk.y = cvt_pk_bf16(kk[t][2] * __builtin_amdgcn_exp2f(-pv[2]), kk[t][3] * __builtin_amdgcn_exp2f(-pv[3]));
                *(LAS u32x2*)(base + (dir * 64 + t) * TST) = wq; *(LAS u32x2*)(base + ((2 + dir) * 64 + t) * TST) = wk;
            } else {
                u32x2 wk; wk.x = cvt_pk_bf16(kk[t][0] * __builtin_amdgcn_exp2f(E[0] - pv[0]), kk[t][1] * __builtin_amdgcn_exp2f(E[1] - pv[1])); wk.y = cvt_pk_bf16(kk[t][2] * __builtin_amdgcn_exp2f(E[2] - pv[2]), kk[t][3] * __builtin_amdgcn_exp2f(E[3] - pv[3]));
                *(LAS u32x2*)(base + ((2 + dir) * 64 + t) * TST) = wk;
            }
        }
        if constexpr (!G3) { if (tg == 0) *(f32x4*)(F_DECAY + ((dir ? chainb : chainf) * NCH + (dir ? idxb : idxf)) * 48 + 4 * dg) = (f32x4){__builtin_amdgcn_exp2f(E[0]), __builtin_amdgcn_exp2f(E[1]), __builtin_amdgcn_exp2f(E[2]), __builtin_amdgcn_exp2f(E[3])}; }
    }
    __syncthreads();
}
__device__ __forceinline__ void gla_g1_unit(const Frame& F, int l, int b, int h, int cc) {
    int m0, rowpos, idxf, idxb; bool lat; gla_chunk_info(b, cc, m0, lat, rowpos, idxf, idxb);
    gla_stage<false>(F, l, b, h, m0, lat, rowpos, idxf, idxb);
    const int lane = F.lane, w = F.wave, g = lane >> 4, c = lane & 15;
    const size_t chainf = ((size_t)(0 * 16 + b) * 4 + h), chainb = ((size_t)(1 * 16 + b) * 4 + h);
    const int q = c >> 2, p = c & 3;
    for (int T = w; T < 36; T += 8) { const int dir = T / 18, rem = T % 18, dt = rem / 6, et = rem % 6;
        const LAS unsigned char* KH = F.lds + GB_T + (2 + dir) * 64 * TST; const LAS unsigned char* Vb = F.lds + GB_V;
        f32x4 acc = (f32x4){0.f, 0.f, 0.f, 0.f};
#pragma unroll
        for (int ks = 0; ks < 2; ++ks) { const int tr0 = 32 * ks + 8 * g + q;
            const bf16x8 ka = tr_pair(KH + tr0 * TST + (16 * dt + 4 * p) * 2, KH + (tr0 + 4) * TST + (16 * dt + 4 * p) * 2);
            const bf16x8 vb = tr_pair(Vb + tr0 * VST + (16 * et + 4 * p) * 2, Vb + (tr0 + 4) * VST + (16 * et + 4 * p) * 2);
            acc = __builtin_amdgcn_mfma_f32_16x16x32_bf16(ka, vb, acc, 0, 0, 0); }
        bf16* gp = F_GST + ((dir ? chainb : chainf) * NCH + (dir ? idxb : idxf)) * 4608 + (size_t)(16 * dt + 4 * g) * 96 + 16 * et + c;
#pragma unroll
        for (int j = 0; j < 4; ++j) gp[j * 96] = (bf16)(cvt_pk_bf16(acc[j], 0.f) & 0xffffu); }
    __syncthreads();
}
__device__ __forceinline__ void phase_gla_g2(const Frame& F) {
    const int n = 2 * 16 * 4 * 2304;
    for (int i = F.bid * 512 + F.tid; i < n; i += F.G * 512) { const int chain = i / 2304, de2 = i % 2304, d = de2 / 48;
        unsigned* base = (unsigned*)(F_GST + (size_t)chain * NCH * 4608) + de2; const float* dc = F_DECAY + (size_t)chain * NCH * 48 + d;
        unsigned tv[NCH]; float dv[NCH];
#pragma unroll
        for (int c = 0; c < NCH; ++c) { tv[c] = base[(size_t)c * 2304]; dv[c] = dc[c * 48]; }
        float r0 = 0.f, r1 = 0.f;
#pragma unroll
        for (int c = 0; c < NCH; ++c) { const float t0 = bflo(tv[c]), t1 = bfhi(tv[c]); tv[c] = cvt_pk_bf16(r0, r1); r0 = dv[c] * r0 + t0; r1 = dv[c] * r1 + t1; }
#pragma unroll
        for (int c = 0; c < NCH; ++c) base[(size_t)c * 2304] = tv[c]; }
}
__device__ __forceinline__ void gla_g3_unit(const Frame& F, int l, int b, int h, int cc) {
    LAS float* ssx = (LAS float*)(F.lds + GB_X);
    int m0, rowpos, idxf, idxb; bool lat; gla_chunk_info(b, cc, m0, lat, rowpos, idxf, idxb);
    gla_stage<true>(F, l, b, h, m0, lat, rowpos, idxf, idxb);
    const int lane = F.lane, w = F.wave, g = lane >> 4, c = lane & 15;
    const int tt = w & 3, eh = w >> 2, q = c >> 2, p = c & 3;
    const int mrow = m0 + 16 * tt + c; const float* gn = inptr(F, 13) + l * 384 + h * 96;
    u32x2 gtv[3]; f32x4 gnv[3];
#pragma unroll
    for (int k = 0; k < 3; ++k) { const int e = 16 * (3 * eh + k) + 4 * g; gtv[k] = *(const u32x2*)(F_PX + (size_t)mrow * NPX + C_GG + h * 96 + e); gnv[k] = *(const f32x4*)(gn + e); }
    const LAS unsigned char* QFb = F.lds + GB_T; const LAS unsigned char* QBb = QFb + 64 * TST; const LAS unsigned char* KFb = QFb + 128 * TST; const LAS unsigned char* KBb = QFb + 192 * TST;
    const bf16x8 qf0 = *(const LAS bf16x8*)(QFb + (16 * tt + c) * TST + 16 * g), qf1 = *(const LAS bf16x8*)(QFb + (16 * tt + c) * TST + 64 + 16 * g);
    const bf16x8 qb0 = *(const LAS bf16x8*)(QBb + (16 * tt + c) * TST + 16 * g), qb1 = *(const LAS bf16x8*)(QBb + (16 * tt + c) * TST + 64 + 16 * g);
    f32x4 at[4];
#pragma unroll
    for (int si = 0; si < 4; ++si) {
        f32x4 zf = (f32x4){0.f, 0.f, 0.f, 0.f}, zb = zf;
        if (si <= tt) { const bf16x8 k0 = *(const LAS bf16x8*)(KFb + (16 * si + c) * TST + 16 * g), k1 = *(const LAS bf16x8*)(KFb + (16 * si + c) * TST + 64 + 16 * g);
            zf = __builtin_amdgcn_mfma_f32_16x16x32_bf16(k0, qf0, zf, 0, 0, 0); zf = __builtin_amdgcn_mfma_f32_16x16x32_bf16(k1, qf1, zf, 0, 0, 0); }
        if (si >= tt) { const bf16x8 k0 = *(const LAS bf16x8*)(KBb + (16 * si + c) * TST + 16 * g), k1 = *(const LAS bf16x8*)(KBb + (16 * si + c) * TST + 64 + 16 * g);
            zb = __builtin_amdgcn_mfma_f32_16x16x32_bf16(k0, qb0, zb, 0, 0, 0); zb = __builtin_amdgcn_mfma_f32_16x16x32_bf16(k1, qb1, zb, 0, 0, 0); }
        if (si == tt) {
#pragma unroll
            for (int j = 0; j < 4; ++j) { const int sl = 4 * g + j; at[si][j] = (sl <= c ? zf[j] : 0.f) + (sl >= c ? zb[j] : 0.f); } }
        else at[si] = zf + zb;
    }
    f32x4 o[3];
#pragma unroll
    for (int k = 0; k < 3; ++k) o[k] = (f32x4){0.f, 0.f, 0.f, 0.f};
    const LAS unsigned char* Vb = F.lds + GB_V; const LAS unsigned char* SFb = F.lds + GB_SF; const LAS unsigned char* SBb = F.lds + GB_SB;
#pragma unroll
    for (int ks = 0; ks < 2; ++ks) {
        bf16x8 pb; { u32x4 pw = (u32x4){cvt_pk_bf16(at[2 * ks][0], at[2 * ks][1]), cvt_pk_bf16(at[2 * ks][2], at[2 * ks][3]), cvt_pk_bf16(at[2 * ks + 1][0], at[2 * ks + 1][1]), cvt_pk_bf16(at[2 * ks + 1][2], at[2 * ks + 1][3])}; pb = __builtin_bit_cast(bf16x8, pw); }
#pragma unroll
        for (int k = 0; k < 3; ++k) { const int et = 3 * eh + k;
            const bf16x8 va = tr_pair(Vb + (32 * ks + 4 * g + q) * VST + (16 * et + 4 * p) * 2, Vb + (32 * ks + 16 + 4 * g + q) * VST + (16 * et + 4 * p) * 2);
            o[k] = __builtin_amdgcn_mfma_f32_16x16x32_bf16(va, pb, o[k], 0, 0, 0); }
    }
#pragma unroll
    for (int kd = 0; kd < 2; ++kd) {
#pragma unroll
        for (int k = 0; k < 3; ++k) { const int et = 3 * eh + k;
            const bf16x8 sa = tr_pair(SFb + (32 * kd + 8 * g + q) * VST + (16 * et + 4 * p) * 2, SFb + (32 * kd + 8 * g + 4 + q) * VST + (16 * et + 4 * p) * 2);
            o[k] = __builtin_amdgcn_mfma_f32_16x16x32_bf16(sa, kd ? qf1 : qf0, o[k], 0, 0, 0);
            const bf16x8 sb = tr_pair(SBb + (32 * kd + 8 * g + q) * VST + (16 * et + 4 * p) * 2, SBb + (32 * kd + 8 * g + 4 + q) * VST + (16 * et + 4 * p) * 2);
            o[k] = __builtin_amdgcn_mfma_f32_16x16x32_bf16(sb, kd ? qb1 : qb0, o[k], 0, 0, 0); }
    }
    float ss = 0.f;
#pragma unroll
    for (int k = 0; k < 3; ++k) ss += (o[k][0] * o[k][0] + o[k][1] * o[k][1]) + (o[k][2] * o[k][2] + o[k][3] * o[k][3]);
    ss += shx(ss, 16, lane); ss += shx(ss, 32, lane);
    if (g == 0) ssx[w * 16 + c] = ss;
    __syncthreads();
    const float tot = ssx[w * 16 + c] + ssx[(w ^ 4) * 16 + c];
    const float rstd = 1.0f / sqrtf(tot * (1.0f / 96.0f) + EPS);
    const int m = mrow;
#pragma unroll
    for (int k = 0; k < 3; ++k) { const int e = 16 * (3 * eh + k) + 4 * g;
        const u32x2 gt = gtv[k]; const f32x4 gv = gnv[k];
        *(unsigned*)(F_MIX + (size_t)m * D + h * 96 + e) = pk4_fp8(o[k][0] * rstd * gv[0] * silu_f(bflo(gt.x)), o[k][1] * rstd * gv[1] * silu_f(bfhi(gt.x)), o[k][2] * rstd * gv[2] * silu_f(bflo(gt.y)), o[k][3] * rstd * gv[3] * silu_f(bfhi(gt.y))); }
    __syncthreads();
}

__device__ __forceinline__ void phase_final(const Frame& F) {
    const int gw = F.bid * 8 + F.wave, NGW = F.G * 8, lane = F.lane;
    f32x4 gm[4];
#pragma unroll
    for (int j = 0; j < 4; ++j) gm[j] = *(const f32x4*)(inptr(F, 25) + 4 * lane + 256 * j);
    moe_tilebase_to_lds(F, DEPTH - 1);
    const int nrow = (ML - gw + NGW - 1) / NGW;
    int rowA = 0, rowB = 0; float wA = 0.f, wB = 0.f;
    for (int k0 = 0; k0 < nrow; k0 += 64) {
        { const int k = k0 + lane, mi = gw + k * NGW; if (k < nrow) { rowA = moe_slot_row(F, 2 * mi); rowB = moe_slot_row(F, 2 * mi + 1); wA = F_SLOTW[2 * mi] * 0.0625f; wB = F_SLOTW[2 * mi + 1] * 0.0625f; } }
        const int kn = (nrow - k0 < 64) ? nrow - k0 : 64;
        struct Row { u32x2 xb[4]; unsigned y0[4], y1[4]; f32x4 g[4]; float w0, w1; };
        Row R0, R1;
#define FN_LOAD(R, kk) do { const int _m = gw + (k0 + (kk)) * NGW; const bf16* _x = F_XB + (size_t)_m * D; \
            const fp8* _y0 = F_YBUF + (size_t)__builtin_amdgcn_readlane(rowA, (kk)) * D; const fp8* _y1 = F_YBUF + (size_t)__builtin_amdgcn_readlane(rowB, (kk)) * D; \
            R.w0 = __int_as_float(__builtin_amdgcn_readlane(__float_as_int(wA), (kk))); R.w1 = __int_as_float(__builtin_amdgcn_readlane(__float_as_int(wB), (kk))); \
            const float* _g5 = F_MOD + ((size_t)(DEPTH - 1) * 17 + (_m >> 11)) * 6144 + 5 * 1024; \
            _Pragma("unroll") for (int j = 0; j < 4; ++j) { R.xb[j] = *(const u32x2*)(_x + 4 * lane + 256 * j); R.y0[j] = *(const unsigned*)(_y0 + 4 * lane + 256 * j); R.y1[j] = *(const unsigned*)(_y1 + 4 * lane + 256 * j); R.g[j] = *(const f32x4*)(_g5 + 4 * lane + 256 * j); } \
            asm volatile("" ::: "memory"); } while (0)
#define FN_DO(R, kk) do { const int _m = gw + (k0 + (kk)) * NGW; float* _xr = F.out + (size_t)_m * D; f32x4 v[4]; f32x2 _s2 = {0.f, 0.f}; \
            _Pragma("unroll") for (int j = 0; j < 4; ++j) { v[j] = bf4(R.xb[j]) + R.g[j] * (fp84(R.y0[j]) * R.w0 + fp84(R.y1[j]) * R.w1); _s2 += v[j].xy * v[j].xy; _s2 += v[j].zw * v[j].zw; } \
            int _ri = __builtin_amdgcn_readfirstlane(__float_as_int(__builtin_amdgcn_rsqf(wave_sum(_s2[0] + _s2[1], lane) * (1.0f / D) + EPS))); asm volatile("" : "+s"(_ri)); const float _rstd = __int_as_float(_ri); \
            _Pragma("unroll") for (int j = 0; j < 4; ++j) *(f32x4*)(_xr + 4 * lane + 256 * j) = v[j] * _rstd * gm[j]; } while (0)
        FN_LOAD(R0, 0);
        for (int kk = 0; kk < kn; kk += 2) {
            FN_LOAD(R1, (kk + 1 < kn ? kk + 1 : kn - 1)); FN_DO(R0, kk);
            FN_LOAD(R0, (kk + 2 < kn ? kk + 2 : kn - 1)); if (kk + 1 < kn) FN_DO(R1, kk + 1);
        }
#undef FN_LOAD
#undef FN_DO
    }
}

constexpr int NPL = 9, NPHASE = 1 + DEPTH * NPL + 1;
struct Args { const float* in[26]; float* out; unsigned char* ws; int ph_lo, ph_hi; };
#define IN(k) (lo <= (k) && (k) < hi)
#if MK_PER_PHASE
#define SEAM(k) do { } while (0)
#else
#define SEAM(k) do { if (IN(k) && IN((k) + 1)) { XcdBarrier _bb = bar; GAS unsigned* _bp = (GAS unsigned*)(args.ws + WS_CTL) + CW_BAR; asm volatile("" : "+s"(_bp)); _bb.bar = (unsigned*)_bp; xcd_barrier(_bb); if (DUP & 8192) xcd_barrier(_bb); } } while (0)
#endif
#define FRESH() do { int _t = threadIdx.x; asm volatile("" : "+v"(_t)); F.tid = _t; F.lane = _t & 63; F.wave = __builtin_amdgcn_readfirstlane(_t >> 6); \
        GAS unsigned char* _w = (GAS unsigned char*)args.ws; GAS float* _o = (GAS float*)args.out; int _g = gridDim.x, _b = blockIdx.x; asm volatile("" : "+s"(_w), "+s"(_o), "+s"(_g), "+s"(_b)); F.ws = (unsigned char*)_w; F.out = (float*)_o; F.G = _g; F.bid = _b; } while (0)

template <int l>
__device__ __forceinline__ void layer_body(Frame& F, const Args& args, const int lo, const int hi, const XcdBarrier& bar) {
    constexpr int pb = 1 + l * NPL; constexpr bool lastl = (l == DEPTH - 1);
    if (IN(pb + 0) && (EN & 2)) { FRESH(); if (DUP & 2) { phase_norm1<true>(F, l); __syncthreads(); } phase_norm1(F, l); router_fold(F, l); } SEAM(pb + 0);
    if (IN(pb + 1) && (EN & 4)) { FRESH(); pg8::Gemm g{F_HX8, F_WIN + (size_t)l * NPX * D, D}; pg8::StaticOrder S; S.init(MT, NPX, F.G, F.bid); EpiPx E{F_PX, F.ws};
        pg8::gemm_phase<EpiPx, pg8::StaticOrder, true, false, true>(F.lds, g, S, E); if (DUP & 4) pg8::gemm_phase<EpiPx, pg8::StaticOrder, true, false, true>(F.lds, g, S, E); } SEAM(pb + 1);
    if (IN(pb + 2)) {
        XcdBarrier sb = bar; { GAS unsigned* _bp = (GAS unsigned*)(args.ws + WS_CTL) + CW_BAR; asm volatile("" : "+s"(_bp)); sb.bar = (unsigned*)_bp; }
        GAS unsigned* _sp = (GAS unsigned*)(args.ws + WS_CTL) + CW_SPL + 4096 * l; asm volatile("" : "+s"(_sp)); unsigned* slotA = (unsigned*)_sp; unsigned* slotB = slotA + 2048;
#define MIX_CONV(k) do { if constexpr (l == 0) { if ((int)(F.bid % 5) == (k)) { FRESH(); __syncthreads(); moe_convert(F, 0, F.bid, F.G); __syncthreads(); } } } while (0)
        MIX_CONV(0);
        FRESH();
        if (EN & 8) for (int rep = 0; rep < ((DUP & 8) ? 2 : 1); ++rep)
        for (int u = F.bid; u < 16 * 4 * NCH; u += F.G) { const int cc = u % NCH, bh = u / NCH; gla_g1_unit(F, l, bh >> 2, bh & 3, cc); }
        xcd_arrive(sb, slotA);
        MIX_CONV(1);
        FRESH();
        if (EN & 16) for (int rep = 0; rep < ((DUP & 16) ? 2 : 1); ++rep)
        if (F.G == 256) {
            na_latent_phase(F, l);
        } else
        for (int u = F.bid; u < 16 * 6 * 32; u += F.G) { const int r = u & 31, bh = u >> 5; na_unit(F, l, 0, bh / 6, bh % 6, r); }
        if ((EN & 16) && !lastl) for (int u = F.bid; u < 16 * 6 * 4; u += F.G) { const int qb = u & 3, bh = u >> 2; na_unit(F, l, 1, bh / 6, bh % 6, qb); }
        MIX_CONV(2);
        xcd_wait(sb, slotA);
        if (EN & 64) { FRESH(); phase_gla_g2(F); }
        xcd_arrive(sb, slotB);
        MIX_CONV(3);
        FRESH();
        if (EN & 32) for (int rep = 0; rep < ((DUP & 32) ? 2 : 1); ++rep)
        for (int u = F.bid; u < 16 * 64; u += F.G) conv_unit(F, l, (u >> 6) * 2048, 2048, (u & 63) * 32);
        if ((EN & 32) && !lastl) for (int u = (F.G == 256) ? (F.bid + 128) % 256 : F.bid; u < 16 * 8; u += F.G) conv_unit(F, l, ML + (u >> 3) * 256, 256, (u & 7) * 32);
        MIX_CONV(4);
#undef MIX_CONV
        xcd_wait(sb, slotB);
        if (EN & 128) { FRESH(); for (int rep = 0; rep < ((DUP & 128) ? 2 : 1); ++rep) for (int u = F.bid; u < 16 * 4 * NCH; u += F.G) { const int cc = u % NCH, bh = u / NCH; if (lastl && cc < 4) continue; gla_g3_unit(F, l, bh >> 2, bh & 3, cc); } }
    } SEAM(pb + 4);
    if (IN(pb + 5) && (EN & 256)) { FRESH(); pg8::Gemm g{F_MIX, F_WOUT + (size_t)l * D * D, D}; SplitOrder S; S.base.init(lastl ? ML : MT, D, F.G, F.bid);
        EpiResid<l == 0> E{inptr(F, 0), inptr(F, 2), F_XB, F_MOD + (size_t)l * 17 * 6144};
        int split = 1 << 20;
        if constexpr (!lastl) { if (F.G == 256 && F.bid >= 64) split = (F.bid - 64) % 3; }
        S.i0 = 0; S.i1 = split;
        pg8::gemm_phase<EpiResid<l == 0>, SplitOrder, true, false, true>(F.lds, g, S, E);
        if constexpr (!lastl) {
            if (F.G == 256) { if (F.bid >= 64) { __syncthreads(); moe_convert(F, l + 1, F.bid - 64, 192); } } else moe_convert(F, l + 1, F.bid, F.G);
            if (split < 2) { __syncthreads(); S.i0 = split; S.i1 = 1 << 20; pg8::gemm_phase<EpiResid<l == 0>, SplitOrder, true, false, true>(F.lds, g, S, E); } } } SEAM(pb + 5);
    if (IN(pb + 6) && (EN & 512)) { FRESH(); phase_norm2_router(F, l); } SEAM(pb + 6);
    if (IN(pb + 7) && (EN & 1024)) { FRESH(); MoeOrder S; moe_setup(F, l, S, 8); pg8::Gemm g{F_HX8, F_WGU + (size_t)l * NE * 2048 * D, D}; EpiSwiGLU E{F_ACT};
        pg8::gemm_phase<EpiSwiGLU, MoeOrder, true, true, true>(F.lds, g, S, E); if (DUP & 1024) pg8::gemm_phase<EpiSwiGLU, MoeOrder, true, true, true>(F.lds, g, S, E); } SEAM(pb + 7);
    if (IN(pb + 8) && (EN & 2048)) { FRESH(); MoeOrder S; moe_setup(F, l, S, 4); pg8::Gemm g{F_ACT, F_WD + (size_t)l * NE * D * D, D}; EpiYrow E{F_YBUF};
        pg8::gemm_phase<EpiYrow, MoeOrder, true, false, true>(F.lds, g, S, E); if (DUP & 2048) pg8::gemm_phase<EpiYrow, MoeOrder, true, false, true>(F.lds, g, S, E); } SEAM(pb + 8);
}

__global__ void __launch_bounds__(512, 2) fwd_kernel(Args args) {
    extern __shared__ __attribute__((aligned(16))) unsigned char lds_raw[];
    Frame F;
    F.lds = (LAS unsigned char*)lds_raw;
    F.tid = threadIdx.x; F.lane = F.tid & 63; F.wave = __builtin_amdgcn_readfirstlane(F.tid >> 6); F.G = gridDim.x; F.bid = blockIdx.x;
    F.out = args.out; F.ws = args.ws;
    if (F.tid < 26) { const unsigned long long p = (unsigned long long)args.in[F.tid]; LAS unsigned* t = (LAS unsigned*)(F.lds + LDS_PTR) + 2 * F.tid; t[0] = (unsigned)p; t[1] = (unsigned)(p >> 32); }
    volatile LAS unsigned* MISC = (volatile LAS unsigned*)(F.lds + LDS_MISC);
    if (F.tid < 64) MISC[F.tid] = 0u;
    __syncthreads();
#if MK_PER_PHASE
    XcdBarrier bar; bar.bar = nullptr; bar.x = 0; bar.st = nullptr;
#else
    XcdBarrier bar = xcd_barrier_post(F_CTL + CW_BAR, MISC + 8);
#endif
    const int lo = args.ph_lo, hi = args.ph_hi;
    if (IN(0) && (EN & 1)) { FRESH(); phase_prologue(F); if (DUP & 1) { __syncthreads(); phase_prologue(F); } } SEAM(0);
    layer_body<0>(F, args, lo, hi, bar);
    layer_body<1>(F, args, lo, hi, bar);
    layer_body<2>(F, args, lo, hi, bar);
    layer_body<3>(F, args, lo, hi, bar);
    if (IN(NPHASE - 1) && (EN & 4096)) { FRESH(); phase_final(F); }
}
#undef IN
#undef SEAM
#undef FRESH

extern "C" void kernel_launch(void* const* d_in, const int* in_sizes, int n_in, void* d_out, int out_size, void* d_ws, size_t ws_size, hipStream_t stream) {
    static int grid = 0;
    if (grid == 0) {
        if (n_in != 26 || out_size != ML * D || ws_size < WS_END) { fprintf(stderr, "kernel_launch: unexpected problem shape (n_in %d out %d ws %zu)\n", n_in, out_size, ws_size); grid = -1; return; }
        int dev = 0, cus = 0, per_cu = 0;
        if (hipGetDevice(&dev) != hipSuccess || hipDeviceGetAttribute(&cus, hipDeviceAttributeMultiprocessorCount, dev) != hipSuccess) { grid = -1; return; }
        if (hipFuncSetAttribute((const void*)fwd_kernel, hipFuncAttributeMaxDynamicSharedMemorySize, LDS_BYTES) != hipSuccess) { fprintf(stderr, "kernel_launch: hipFuncSetAttribute failed\n"); grid = -1; return; }
        if (hipOccupancyMaxActiveBlocksPerMultiprocessor(&per_cu, (const void*)fwd_kernel, 512, LDS_BYTES) != hipSuccess || per_cu < 1) { fprintf(stderr, "kernel_launch: occupancy query says %d\n", per_cu); }
        (void)hipGetLastError();
        grid = cus;
    }
    if (grid < 0) return;
    (void)hipMemsetAsync((char*)d_ws + WS_CTL, 0, CTL_ZERO_BYTES, stream);
    Args a{};
    for (int i = 0; i < 26; ++i) a.in[i] = (const float*)d_in[i];
    a.out = (float*)d_out; a.ws = (unsigned char*)d_ws;
#if MK_PER_PHASE
    for (int p = 0; p < NPHASE; ++p) { a.ph_lo = p; a.ph_hi = p + 1; hipLaunchKernelGGL(fwd_kernel, dim3(grid), dim3(512), LDS_BYTES, stream, a); }
#else
    a.ph_lo = 0; a.ph_hi = NPHASE; hipLaunchKernelGGL(fwd_kernel, dim3(grid), dim3(512), LDS_BYTES, stream, a);
#endif
}
```
